# Optimizing an MI355X kernel written in HIP

```python
import jax
import jax.numpy as jnp
from jax import lax
import numpy as np

D_MODEL = 1024
BATCH = 8
SEQ = 4096
DEPTH = 4

RET_HEADS = 4
RET_HEAD_DIM = D_MODEL // 2 // RET_HEADS
RET_VALUE_DIM = D_MODEL // 2 // RET_HEADS
RET_CHUNK = 128
RET_WIDTH = RET_HEADS * RET_VALUE_DIM
WIN_Q_HEADS = 8
WIN_KV_HEADS = 2
WIN_HEAD_DIM = D_MODEL // 2 // WIN_Q_HEADS
WINDOW = 128
WIN_BLOCK = WINDOW
WIN_WIDTH = WIN_Q_HEADS * WIN_HEAD_DIM
FOURIER_GROUPS = 4
ROPE_THETA = 10000.0
N_GROUPS = 4
EXPERTS_PER_GROUP = 8
N_EXPERTS = N_GROUPS * EXPERTS_PER_GROUP
TOP_K = 2
EXPERT_HIDDEN = D_MODEL // 2
LN_EPS = 1e-5
GN_EPS = 1e-6
DEEPNORM_ALPHA = (2.0 * DEPTH) ** 0.25
DEEPNORM_BETA = (8.0 * DEPTH) ** -0.25
N_EVEN = (DEPTH + 1) // 2
N_ODD = DEPTH // 2
RET_QK = RET_HEADS * RET_HEAD_DIM
WIN_KV = WIN_KV_HEADS * WIN_HEAD_DIM
EVEN_SPLITS = tuple(np.cumsum([RET_QK, RET_QK, RET_WIDTH, RET_WIDTH, WIN_WIDTH, WIN_KV])[:].tolist())
IN_EVEN = 2 * RET_QK + 2 * RET_WIDTH + WIN_WIDTH + 2 * WIN_KV

kernel_name = "hybrid_retention_swa_fnet_hmoe_encoder"


def layer_norm(x, gain, bias):
    xf = x.astype(jnp.float32)
    mu = jnp.mean(xf, axis=-1, keepdims=True)
    var = jnp.mean(jnp.square(xf - mu), axis=-1, keepdims=True)
    y = (xf - mu) * lax.rsqrt(var + LN_EPS) * gain.astype(jnp.float32) + bias.astype(jnp.float32)
    return y.astype(x.dtype)


def rope(x, pos):
    d = x.shape[-1]
    half = d // 2
    inv = ROPE_THETA ** (-jnp.arange(half, dtype=jnp.float32) / half)
    ang = pos.astype(jnp.float32)[:, None] * inv[None, :]
    cos = jnp.cos(ang)[None, :, None, :]
    sin = jnp.sin(ang)[None, :, None, :]
    xf = x.astype(jnp.float32)
    x1, x2 = xf[..., :half], xf[..., half:]
    return jnp.concatenate([x1 * cos - x2 * sin, x1 * sin + x2 * cos], axis=-1).astype(x.dtype)


def retention_one_direction(q, k, v, log_gamma, include_diag):
    B, H, S, dk = q.shape
    dv = v.shape[-1]
    C = RET_CHUNK
    NC = S // C
    qc = q.reshape(B, H, NC, C, dk)
    kc = k.reshape(B, H, NC, C, dk)
    vc = v.reshape(B, H, NC, C, dv)
    pos = jnp.arange(C, dtype=jnp.float32)
    lg = log_gamma[:, None, None]
    diff = pos[:, None] - pos[None, :]
    mask = diff >= 0 if include_diag else diff > 0
    dmat = jnp.where(mask[None], jnp.exp(lg * jnp.maximum(diff, 0.0)[None]), 0.0)
    scores = jnp.einsum('bhncd,bhnmd->bhncm', qc, kc) * dmat[None, :, None]
    y_inner = jnp.einsum('bhncm,bhnmv->bhncv', scores, vc)
    zeta = jnp.exp(log_gamma[:, None] * (C - 1.0 - pos)[None])
    kv = jnp.einsum('bhnmd,bhnmv->nbhdv', kc * zeta[None, :, None, :, None], vc)
    chunk_decay = jnp.exp(log_gamma * C)[None, :, None, None]

    def step(state, kv_n):
        return state * chunk_decay + kv_n, state

    _, r_prev = lax.scan(step, jnp.zeros((B, H, dk, dv), jnp.float32), kv)
    xi = jnp.exp(log_gamma[:, None] * (pos + 1.0)[None])
    y_cross = jnp.einsum('bhncd,nbhdv->bhncv', qc * xi[None, :, None, :, None], r_prev)
    return (y_inner + y_cross).reshape(B, H, S, dv)


def bidirectional_retention(q, k, v, decay_logit):
    qf = jnp.transpose(q.astype(jnp.float32), (0, 2, 1, 3))
    kf = jnp.transpose(k.astype(jnp.float32), (0, 2, 1, 3))
    vf = jnp.transpose(v.astype(jnp.float32), (0, 2, 1, 3))
    log_gamma = jax.nn.log_sigmoid(decay_logit.astype(jnp.float32))
    fwd = retention_one_direction(qf, kf, vf, log_gamma[0], True)
    bwd = jnp.flip(retention_one_direction(jnp.flip(qf, 2), jnp.flip(kf, 2), jnp.flip(vf, 2),
                                           log_gamma[1], False), 2)
    return jnp.transpose(fwd + bwd, (0, 2, 1, 3))


def banded_keys(t):
    B, S, Hkv, d = t.shape
    NB = S // WIN_BLOCK
    tp = jnp.pad(t, ((0, 0), (WINDOW, WINDOW), (0, 0), (0, 0))).reshape(B, NB + 2, WIN_BLOCK, Hkv, d)
    return jnp.concatenate([tp[:, :-2], tp[:, 1:-1], tp[:, 2:]], axis=2)


def window_attention_with_sink(q, k, v, sink_logit):
    B, S, Hq, d = q.shape
    Hkv = k.shape[2]
    G = Hq // Hkv
    NB = S // WIN_BLOCK
    qb = q.reshape(B, NB, WIN_BLOCK, Hkv, G, d)
    kb = banded_keys(k)
    vb = banded_keys(v)
    s = jnp.einsum('bnqhgd,bnkhd->bnhgqk', qb, kb).astype(jnp.float32)
    i = jnp.arange(WIN_BLOCK)[:, None]
    j = jnp.arange(3 * WIN_BLOCK)[None, :]
    rel_ok = jnp.abs(i - j + WINDOW) <= WINDOW
    kpos = jnp.arange(NB)[:, None] * WIN_BLOCK + jnp.arange(3 * WIN_BLOCK)[None, :] - WINDOW
    in_ok = (kpos >= 0) & (kpos < S)
    mask = rel_ok[None] & in_ok[:, None, :]
    s = jnp.where(mask[None, :, None, None], s, -1e30)
    sink = jnp.broadcast_to(sink_logit.astype(jnp.float32).reshape(1, 1, Hkv, G, 1, 1), s.shape[:-1] + (1,))
    p = jax.nn.softmax(jnp.concatenate([s, sink], axis=-1), axis=-1)[..., :-1]
    o = jnp.einsum('bnhgqk,bnkhd->bnqhgd', p.astype(v.dtype), vb)
    return o.reshape(B, S, Hq * d)


def even_mixer(x, w_in, decay_logit, gn_gain, sink_logit, w_out, pos):
    B, S, _ = x.shape
    h = x @ w_in
    qa, ka, va, ga, qb, kb, vb = jnp.split(h, EVEN_SPLITS, axis=-1)
    qa = rope(qa.reshape(B, S, RET_HEADS, RET_HEAD_DIM), pos)
    ka = rope(ka.reshape(B, S, RET_HEADS, RET_HEAD_DIM), pos) * (RET_HEAD_DIM ** -0.5)
    va = va.reshape(B, S, RET_HEADS, RET_VALUE_DIM)
    ya = bidirectional_retention(qa, ka, va, decay_logit)
    mu = jnp.mean(ya, axis=-1, keepdims=True)
    var = jnp.mean(jnp.square(ya - mu), axis=-1, keepdims=True)
    ya = ((ya - mu) * lax.rsqrt(var + GN_EPS)).reshape(B, S, RET_WIDTH) * gn_gain.astype(jnp.float32)
    ya = jax.nn.silu(ga) * ya.astype(x.dtype)
    qb = rope(qb.reshape(B, S, WIN_Q_HEADS, WIN_HEAD_DIM), pos) * (WIN_HEAD_DIM ** -0.5)
    kb = rope(kb.reshape(B, S, WIN_KV_HEADS, WIN_HEAD_DIM), pos)
    vb = vb.reshape(B, S, WIN_KV_HEADS, WIN_HEAD_DIM)
    yb = window_attention_with_sink(qb, kb, vb, sink_logit)
    return jnp.concatenate([ya, yb], axis=-1) @ w_out


def fourier_mixer(x, w_out):
    B, S, D = x.shape
    xg = x.astype(jnp.float32).reshape(B, S, FOURIER_GROUPS, D // FOURIER_GROUPS)
    y = jnp.fft.fft2(xg, axes=(1, 3), norm='ortho').real.reshape(B, S, D)
    return y.astype(x.dtype) @ w_out


def hierarchical_moe(x, w_coarse, b_coarse, w_fine, b_fine, w_gate, w_up, w_down):
    B, S, D = x.shape
    xt = x.reshape(B * S, D)
    T = B * S
    coarse = (xt @ w_coarse + b_coarse).astype(jnp.float32)
    p_group, g_idx = lax.top_k(jax.nn.softmax(coarse, axis=-1), 1)
    fine = (xt @ w_fine + b_fine).astype(jnp.float32).reshape(T, N_GROUPS, EXPERTS_PER_GROUP)
    fine_g = jnp.take_along_axis(fine, g_idx[:, :, None], axis=1)[:, 0]
    top_val, top_idx = lax.top_k(fine_g, TOP_K)
    gate = jax.nn.softmax(top_val, axis=-1) * p_group
    expert_id = (g_idx * EXPERTS_PER_GROUP + top_idx).reshape(-1)
    order = jnp.argsort(expert_id)
    tok = order // TOP_K
    sizes = jnp.bincount(expert_id, length=N_EXPERTS).astype(jnp.int32)
    xs = xt[tok]
    hid = jax.nn.silu(lax.ragged_dot(xs, w_gate, sizes)) * lax.ragged_dot(xs, w_up, sizes)
    ys = lax.ragged_dot(hid, w_down, sizes) * gate.reshape(-1)[order][:, None].astype(x.dtype)
    out = jax.ops.segment_sum(ys, tok, num_segments=T)
    return out.reshape(B, S, D)


def setup_inputs(seed: int = 0) -> dict:
    key = jax.random.key(seed)
    ks = jax.random.split(key, 20)
    f32 = jnp.float32
    nrm = lambda k, shape: jax.random.normal(k, shape, f32)
    base_logit = jnp.log(2.0 ** (5.0 + jnp.arange(RET_HEADS, dtype=f32)) - 1.0)
    return {
        "x": nrm(ks[0], (BATCH, SEQ, D_MODEL)),
        "w_in_even": nrm(ks[1], (N_EVEN, D_MODEL, IN_EVEN)) * D_MODEL ** -0.5,
        "ret_decay_logit": base_logit[None, None, :] + 0.1 * nrm(ks[2], (N_EVEN, 2, RET_HEADS)),
        "ret_gn_gain": 1.0 + 0.02 * nrm(ks[3], (N_EVEN, RET_WIDTH)),
        "sink_logit": 0.5 * nrm(ks[4], (N_EVEN, WIN_Q_HEADS)),
        "w_out_even": nrm(ks[5], (N_EVEN, D_MODEL, D_MODEL)) * D_MODEL ** -0.5 * DEEPNORM_BETA,
        "w_out_fourier": nrm(ks[6], (N_ODD, D_MODEL, D_MODEL)) * D_MODEL ** -0.5 * DEEPNORM_BETA,
        "ln1_gain": 1.0 + 0.02 * nrm(ks[7], (DEPTH, D_MODEL)),
        "ln1_bias": 0.02 * nrm(ks[8], (DEPTH, D_MODEL)),
        "ln2_gain": 1.0 + 0.02 * nrm(ks[9], (DEPTH, D_MODEL)),
        "ln2_bias": 0.02 * nrm(ks[10], (DEPTH, D_MODEL)),
        "router_coarse_w": nrm(ks[11], (DEPTH, D_MODEL, N_GROUPS)) * D_MODEL ** -0.5,
        "router_coarse_b": 0.01 * nrm(ks[12], (DEPTH, N_GROUPS)),
        "router_fine_w": nrm(ks[13], (DEPTH, D_MODEL, N_EXPERTS)) * D_MODEL ** -0.5,
        "router_fine_b": 0.01 * nrm(ks[14], (DEPTH, N_EXPERTS)),
        "expert_w_gate": nrm(ks[15], (DEPTH, N_EXPERTS, D_MODEL, EXPERT_HIDDEN)) * D_MODEL ** -0.5,
        "expert_w_up": nrm(ks[16], (DEPTH, N_EXPERTS, D_MODEL, EXPERT_HIDDEN)) * D_MODEL ** -0.5,
        "expert_w_down": nrm(ks[17], (DEPTH, N_EXPERTS, EXPERT_HIDDEN, D_MODEL)) * EXPERT_HIDDEN ** -0.5 * DEEPNORM_BETA,
    }


def reference(x, w_in_even, ret_decay_logit, ret_gn_gain, sink_logit, w_out_even, w_out_fourier,
              ln1_gain, ln1_bias, ln2_gain, ln2_bias, router_coarse_w, router_coarse_b,
              router_fine_w, router_fine_b, expert_w_gate, expert_w_up, expert_w_down):
    pos = jnp.arange(x.shape[1], dtype=jnp.int32)
    for layer in range(DEPTH):
        if layer % 2 == 0:
            e = layer // 2
            mix = even_mixer(x, w_in_even[e], ret_decay_logit[e], ret_gn_gain[e], sink_logit[e],
                             w_out_even[e], pos)
        else:
            mix = fourier_mixer(x, w_out_fourier[layer // 2])
        x = layer_norm(DEEPNORM_ALPHA * x + mix, ln1_gain[layer], ln1_bias[layer])
        ffn = hierarchical_moe(x, router_coarse_w[layer], router_coarse_b[layer], router_fine_w[layer],
                               router_fine_b[layer], expert_w_gate[layer], expert_w_up[layer],
                               expert_w_down[layer])
        x = layer_norm(DEEPNORM_ALPHA * x + ffn, ln2_gain[layer], ln2_bias[layer])
    return x
```

```cpp
#include <hip/hip_runtime.h>
#include <cstdio>
#include <cstdint>

#ifndef N_LAUNCH_MODE
#define N_LAUNCH_MODE 0
#endif

#define LAS __attribute__((address_space(3)))
typedef unsigned short bf16_t;
typedef short bf16x8 __attribute__((ext_vector_type(8)));
typedef short bf16x4 __attribute__((ext_vector_type(4)));
typedef float f32x4 __attribute__((ext_vector_type(4)));
typedef float f32x2 __attribute__((ext_vector_type(2)));
typedef unsigned u32x4 __attribute__((ext_vector_type(4)));
typedef unsigned u32x2 __attribute__((ext_vector_type(2)));
typedef LAS unsigned char* ldsp;

constexpr int NB = 8, SEQ = 4096, DM = 1024, NT = NB * SEQ, DEPTH = 4;
constexpr int IN_EVEN = 2816;
constexpr int C_QA = 0, C_KA = 512, C_VA = 1024, C_GA = 1536, C_QB = 2048, C_KB = 2560, C_VB = 2688;
constexpr int NEXP = 32, EH = 512;
constexpr int RMAX = 65536 + 32 * 256;
constexpr float LN_EPS = 1e-5f, GN_EPS = 1e-6f;
constexpr float ALPHA = 1.681792830507429f;

constexpr size_t MiB = 1u << 20;
constexpr size_t WS_CTL = 0, CTL_BYTES = 1 * MiB;
constexpr size_t WS_ROPE64 = 1 * MiB;
constexpr size_t WS_ROPE32 = 3 * MiB;
constexpr size_t WS_FFT1 = 4 * MiB;
constexpr size_t WS_FFT2 = 5 * MiB;
constexpr size_t WS_CHDFT = 5 * MiB + 65536;
constexpr size_t WS_WRT = 6 * MiB;
constexpr size_t WS_ROUTE = 8 * MiB;
constexpr size_t WS_WIN = 12 * MiB;
constexpr size_t WS_WOUT = 23 * MiB;
constexpr size_t WS_WFO = 27 * MiB;
constexpr size_t WS_WPP = 31 * MiB;
constexpr size_t WS_WGU = 39 * MiB;
constexpr size_t WS_WD = 295 * MiB;
constexpr size_t WS_XB = 423 * MiB;
constexpr size_t WS_X1B = 487 * MiB;
constexpr size_t WS_SCR = 551 * MiB;
constexpr size_t WS_END = 951 * MiB;
constexpr size_t SC_H = 0;
constexpr size_t SC_KV = 176 * MiB;
constexpr size_t SC_RT = 304 * MiB;
constexpr size_t SC_YCAT = 176 * MiB;
constexpr size_t SC_YPRE = 0;
constexpr size_t SC_A1 = 0;
constexpr size_t SC_V2 = 128 * MiB;
constexpr size_t SC_XS = 0;
constexpr size_t SC_HID = 144 * MiB;
constexpr size_t SC_YS = 216 * MiB;
constexpr size_t RT_TOKE = 0;
constexpr size_t RT_TOKG = 256 * 1024;
constexpr size_t RT_TOKR = 512 * 1024;
constexpr size_t RT_TOKP = 768 * 1024;
constexpr size_t RT_BCNT = 1024 * 1024;
constexpr size_t RT_SGATE = 1024 * 1024 + 65536;
constexpr size_t RT_TILEE = 2048 * 1024;
constexpr int CW_BAR = 4096;

constexpr int LDS_BYTES = 155648;
constexpr int MISC_OFF = 151552;

__device__ __forceinline__ unsigned f2bf(float f) { unsigned u = __builtin_bit_cast(unsigned, f); return (u + 0x7fffu + ((u >> 16) & 1u)) >> 16; }
__device__ __forceinline__ unsigned pk2(float lo, float hi) { return f2bf(lo) | (f2bf(hi) << 16); }
__device__ __forceinline__ float bf_lo(unsigned u) { return __builtin_bit_cast(float, u << 16); }
__device__ __forceinline__ float bf_hi(unsigned u) { return __builtin_bit_cast(float, u & 0xffff0000u); }
__device__ __forceinline__ float bf2f(bf16_t h) { return __builtin_bit_cast(float, (unsigned)h << 16); }
__device__ __forceinline__ float wave_sum(float v) {
#pragma unroll
    for (int o = 1; o < 64; o <<= 1) v += __shfl_xor(v, o);
    return v;
}
__device__ __forceinline__ float silu_f(float g) { return g / (1.0f + __expf(-g)); }

__device__ __forceinline__ void sincos_turn(double frac, double& s, double& c) {
    const double r = frac * 6.283185307179586 * 0.125;
    const double r2 = r * r;
    double sp = 1.0 / 6227020800.0;
    sp = sp * r2 * -1.0 + 1.0 / 39916800.0; sp = sp * r2 * -1.0 + 1.0 / 362880.0; sp = sp * r2 * -1.0 + 1.0 / 5040.0; sp = sp * r2 * -1.0 + 1.0 / 120.0; sp = sp * r2 * -1.0 + 1.0 / 6.0; sp = sp * r2 * -1.0 + 1.0;
    double ss = sp * r;
    double cp = 1.0 / 479001600.0;
    cp = cp * r2 * -1.0 + 1.0 / 3628800.0; cp = cp * r2 * -1.0 + 1.0 / 40320.0; cp = cp * r2 * -1.0 + 1.0 / 720.0; cp = cp * r2 * -1.0 + 1.0 / 24.0; cp = cp * r2 * -1.0 + 0.5; cp = cp * r2 * -1.0 + 1.0;
    double cc = cp;
#pragma unroll
    for (int i = 0; i < 3; ++i) { const double s2 = 2.0 * ss * cc, c2 = cc * cc - ss * ss; ss = s2; cc = c2; }
    s = ss; c = cc;
}
__device__ __forceinline__ void sincos_frac(int p, int N, double& s, double& c) {
    p %= N; if (p < 0) p += N; if (2 * p >= N) p -= N;
    sincos_turn((double)p / (double)N, s, c);
}

#define XB_TMO      128
#define XB_XCNT(j)  (256  + 64 * (j))
#define XB_XSUB(j)  (1280 + 64 * (j))
#define XB_XGEN(j)  (2304 + 64 * (j))
#define XB_TOP      3328
#define XB_TOPGEN   3392
#define XCD_BAR_WORDS 3456
#define XB_SPIN_CAP (1u << 20)
__device__ __forceinline__ unsigned xb_ld(unsigned* p)              { return __hip_atomic_load(p, __ATOMIC_RELAXED, __HIP_MEMORY_SCOPE_AGENT); }
__device__ __forceinline__ unsigned xb_add(unsigned* p, unsigned v) { return __hip_atomic_fetch_add(p, v, __ATOMIC_RELAXED, __HIP_MEMORY_SCOPE_AGENT); }
__device__ __forceinline__ unsigned xb_xcc_id() { return (unsigned)__builtin_amdgcn_s_getreg((3 << 11) | 20) & 0xFu; }
#define XB_SPIN(cond, bar) do { unsigned _sp = 0; while (cond) { __builtin_amdgcn_s_sleep(1); \
    if ((++_sp & 255u) == 0u) { if (xb_ld(&(bar)[XB_TMO])) break; if (_sp > XB_SPIN_CAP) { atomicAdd(&(bar)[XB_TMO], 1u); break; } } } } while (0)
struct XcdBarrier { unsigned* bar; unsigned x; volatile LAS unsigned* st; };
__device__ __forceinline__ XcdBarrier xcd_barrier_post(unsigned* bar, volatile LAS unsigned* st) {
    XcdBarrier b; b.bar = bar; b.x = xb_xcc_id(); b.st = st;
    if (threadIdx.x == 0) (void)xb_add(&bar[XB_XCNT(b.x)], 1u);
    return b;
}
__device__ __forceinline__ void xcd_barrier_complete(unsigned* bar, unsigned x, unsigned& nloc, unsigned& nx) {
    const unsigned G = gridDim.x * gridDim.y * gridDim.z;
    unsigned sum, cnt, mine, sp = 0u;
    for (;;) {
        sum = 0u; cnt = 0u; mine = 0u;
#pragma unroll
        for (unsigned j = 0; j < 16; ++j) { const unsigned c = xb_ld(&bar[XB_XCNT(j)]); sum += c; cnt += (c > 0u) ? 1u : 0u; mine = (j == x) ? c : mine; }
        if (sum == G) break;
        __builtin_amdgcn_s_sleep(1);
        if ((++sp & 255u) == 0u) { if (xb_ld(&bar[XB_TMO])) break; if (sp > XB_SPIN_CAP) { atomicAdd(&bar[XB_TMO], 1u); break; } }
    }
    nloc = mine > 0u ? mine : 1u; nx = cnt > 0u ? cnt : 1u;
}
__device__ __forceinline__ void xcd_barrier(const XcdBarrier& b) {
    asm volatile("s_waitcnt vmcnt(0)" ::: "memory");
    __syncthreads();
    if (threadIdx.x == 0) {
        unsigned* bar = b.bar;
        __builtin_amdgcn_s_waitcnt(0);
        unsigned nloc = b.st[0], nx = b.st[1];
        if (nloc == 0u) { xcd_barrier_complete(bar, b.x, nloc, nx); b.st[0] = nloc; b.st[1] = nx; }
        const unsigned old = xb_add(&bar[XB_XSUB(b.x)], 1u);
        const unsigned gen = old / nloc;
        if (old + 1u == (gen + 1u) * nloc) {
            __builtin_amdgcn_fence(__ATOMIC_RELEASE, "agent");
            asm volatile("s_waitcnt vmcnt(0)" ::: "memory");
            const unsigned og = xb_add(&bar[XB_TOP], 1u);
            const unsigned tg = og / nx;
            if (og + 1u == (tg + 1u) * nx) xb_add(&bar[XB_TOPGEN], 1u);
            else XB_SPIN(xb_ld(&bar[XB_TOPGEN]) == tg, bar);
            __builtin_amdgcn_fence(__ATOMIC_ACQUIRE, "agent");
            xb_add(&bar[XB_XGEN(b.x)], 1u);
            asm volatile("s_waitcnt vmcnt(0)" ::: "memory");
        } else {
            XB_SPIN(xb_ld(&bar[XB_XGEN(b.x)]) == gen, bar);
            __builtin_amdgcn_fence(__ATOMIC_ACQUIRE, "agent");
            asm volatile("s_waitcnt vmcnt(0)" ::: "memory");
        }
    }
    __syncthreads();
}

namespace pg8 {
constexpr int BM = 256, BK = 64, HALF = 128, HTB = HALF * BK * 2, STAGE_BYTES = 8 * HTB, NXCD = 8, WGM = 8;
__host__ __device__ __forceinline__ int lds_byte(int r, int c) { const int st = (r >> 4) * 2 + (c >> 5), rr = r & 15, cc = c & 31, ob = rr * 64 + cc * 2; return st * 1024 + (ob ^ (((ob >> 9) & 1) << 5)); }
__host__ __device__ __forceinline__ void stage_rc(int b, int& R, int& C) { const int st = b / 1024, sb = b % 1024, swz = sb ^ (((sb >> 9) & 1) << 5); R = (st >> 1) * 16 + swz / 64; C = (st & 1) * 32 + (swz % 64) / 2; }
__host__ __device__ __forceinline__ int perm32(int rho) { const int n = rho >> 4, i = rho & 15; return 8 * (i >> 2) + 4 * n + (i & 3); }

struct Unit { int pm, pn, tag, pad; const char* a; const char* b; };

__device__ __forceinline__ bool static_order(int i, int G, int c, int nM, int nN, int& pm, int& pn) {
    const int nwg = nM * nN; const long L = (long)i * G + c; if (L >= nwg) return false;
    int wgid = (int)L; { const int q = nwg / NXCD, r = nwg % NXCD, xcd = wgid % NXCD, off = wgid / NXCD; wgid = (xcd < r ? xcd * (q + 1) : r * (q + 1) + (xcd - r) * q) + off; }
    const int nig = WGM * nN, gid = wgid / nig, fm = gid * WGM, gsz = (nM - fm) < WGM ? (nM - fm) : WGM;
    pm = fm + ((wgid % nig) % gsz); pn = (wgid % nig) / gsz; return true;
}
struct DenseOrder {
    const char* A; const char* Bt; int lda, ldb, nM, nN, G, c;
    __device__ __forceinline__ bool next(int i, Unit& u) const {
        if (!static_order(i, G, c, nM, nN, u.pm, u.pn)) return false;
        u.tag = 0; u.pad = 0; u.a = A + (size_t)u.pm * BM * lda * 2; u.b = Bt + (size_t)u.pn * BM * ldb * 2; return true;
    }
};
struct GroupedOrder {
    const char* A; const char* W; const int* tile_e; size_t estride; int lda, ldb, nM, nN, G, c;
    __device__ __forceinline__ bool next(int i, Unit& u) const {
        if (!static_order(i, G, c, nM, nN, u.pm, u.pn)) return false;
        const int e = __builtin_amdgcn_readfirstlane(tile_e[u.pm]);
        u.tag = e; u.pad = 0; u.a = A + (size_t)u.pm * BM * lda * 2; u.b = W + (size_t)e * estride + (size_t)u.pn * BM * ldb * 2; return true;
    }
};

__device__ __forceinline__ unsigned cvt_pk_bf16(float lo, float hi) { unsigned r; asm volatile("v_cvt_pk_bf16_f32 %0, %1, %2" : "=v"(r) : "v"(lo), "v"(hi)); return r; }

template <class Epi, class Sched, bool ALIGN_EPI>
__device__ __forceinline__ void gemm_phase(ldsp lds, const int tid, const int lda, const int ldb, const int K, const Sched& S, const Epi& E) {
    const int wid = __builtin_amdgcn_readfirstlane(tid >> 6), lane = tid & 63, wr = wid >> 2, wc = wid & 3, fr = lane & 15, fq = lane >> 4;
    const int nt = K / BK;
    unsigned voffA[2], voffB[2];
#pragma unroll
    for (int i = 0; i < 2; ++i) { int R, C; stage_rc(tid * 16 + i * 8192, R, C); const int Rb = Epi::PERM ? ((R & ~31) + perm32(R & 31)) : R;
        voffA[i] = (unsigned)(R * lda + C) * 2u; voffB[i] = (unsigned)(Rb * ldb + C) * 2u; }
    const size_t kstep = (size_t)(BK * 2);
    const size_t hstepA = (size_t)HALF * lda * 2, hstepB = (size_t)HALF * ldb * 2;
    const unsigned ldsw = (unsigned)wid * 1024u;
    const int aoff = lds_byte(wr * 64 + fr, fq * 8), boff = lds_byte(wc * 32 + fr, fq * 8);
#define PG8_SA(b, h) (((b) * 2 + (h)) * HTB)
#define PG8_SB(b, h) ((4 + (b) * 2 + (h)) * HTB)
#define PG8_STAGE(bufoff, gbase, voff) do { _Pragma("unroll") for (int _i = 0; _i < 2; ++_i) \
        __builtin_amdgcn_global_load_lds((const unsigned*)((const char*)(gbase) + (voff)[_i]), (LAS unsigned*)(lds + (bufoff) + ldsw + _i * 8192), 16, 0, 0); } while (0)
#define PG8_LDA(dst, b, h) do { _Pragma("unroll") for (int m = 0; m < 4; ++m) _Pragma("unroll") for (int k = 0; k < 2; ++k) dst[m][k] = *(const LAS bf16x8*)(lds + PG8_SA(b, h) + aoff + m * 2048 + k * 1024); } while (0)
#define PG8_LDB(dst, b, h) do { _Pragma("unroll") for (int n = 0; n < 2; ++n) _Pragma("unroll") for (int k = 0; k < 2; ++k) dst[n][k] = *(const LAS bf16x8*)(lds + PG8_SB(b, h) + boff + n * 2048 + k * 1024); } while (0)
#define PG8_MMA(ai, bj, At, Bt) do { __builtin_amdgcn_s_setprio(1); _Pragma("unroll") for (int m = 0; m < 4; ++m) _Pragma("unroll") for (int n = 0; n < 2; ++n) _Pragma("unroll") for (int k = 0; k < 2; ++k) \
        acc[ai][bj][m][n] = __builtin_amdgcn_mfma_f32_16x16x32_bf16(Bt[n][k], At[m][k], acc[ai][bj][m][n], 0, 0, 0); __builtin_amdgcn_s_setprio(0); } while (0)
#define PG8_WAIT_V(n) asm volatile("s_waitcnt vmcnt(" #n ")" ::: "memory")
#define PG8_WAIT_L(n) asm volatile("s_waitcnt lgkmcnt(" #n ")" ::: "memory")
#define PG8_BAR __builtin_amdgcn_s_barrier()
#define PG8_SCHED __builtin_amdgcn_sched_barrier(0)
    Unit cur, nxt; int ui = 0;
    if (!S.next(0, cur)) return;
    f32x4 acc[2][2][4][2];
#pragma unroll
    for (int a = 0; a < 2; ++a)
#pragma unroll
        for (int b = 0; b < 2; ++b)
#pragma unroll
            for (int m = 0; m < 4; ++m)
#pragma unroll
                for (int n = 0; n < 2; ++n) acc[a][b][m][n] = (f32x4){0.f, 0.f, 0.f, 0.f};
    bf16x8 At[4][2], B0[2][2], B1[2][2];
    const char* cA = cur.a; const char* cB = cur.b;
    PG8_STAGE(PG8_SB(0, 0), cB, voffB); PG8_STAGE(PG8_SB(0, 1), cB + hstepB, voffB); PG8_STAGE(PG8_SA(0, 0), cA, voffA); PG8_STAGE(PG8_SA(0, 1), cA + hstepA, voffA);
    if (wr == 1) PG8_BAR;
    PG8_WAIT_V(2); PG8_BAR;
    PG8_STAGE(PG8_SB(1, 0), cB + kstep, voffB); PG8_STAGE(PG8_SA(1, 0), cA + kstep, voffA); PG8_STAGE(PG8_SB(1, 1), cB + hstepB + kstep, voffB);
    PG8_WAIT_V(6); PG8_BAR;
    for (;;) {
        const bool has_next = S.next(ui + 1, nxt);
        const char* nA = has_next ? nxt.a : cA; const char* nB = has_next ? nxt.b : cB;
#pragma unroll 1
        for (int t = 0; t < nt; t += 2) {
            const bool last = (t == nt - 2);
            const char* a1 = cA + (size_t)(t + 1) * kstep;
            const char* a2 = last ? nA : cA + (size_t)(t + 2) * kstep; const char* b2 = last ? nB : cB + (size_t)(t + 2) * kstep;
            const char* a3 = a2 + kstep; const char* b3 = b2 + kstep;
            PG8_LDB(B0, 0, 0); PG8_LDB(B1, 0, 1); PG8_SCHED; PG8_LDA(At, 0, 0); PG8_STAGE(PG8_SA(1, 1), a1 + hstepA, voffA);
            PG8_WAIT_V(8); PG8_WAIT_L(0); PG8_BAR; PG8_MMA(0, 0, At, B0); PG8_MMA(0, 1, At, B1); PG8_BAR; PG8_SCHED;
            PG8_LDA(At, 0, 1); PG8_STAGE(PG8_SB(0, 0), b2, voffB); PG8_STAGE(PG8_SB(0, 1), b2 + hstepB, voffB); PG8_STAGE(PG8_SA(0, 0), a2, voffA);
            PG8_WAIT_V(8); PG8_WAIT_L(0); PG8_BAR; PG8_MMA(1, 0, At, B0); PG8_MMA(1, 1, At, B1); PG8_BAR; PG8_SCHED;
            PG8_LDB(B0, 1, 0); PG8_LDB(B1, 1, 1); PG8_SCHED; PG8_LDA(At, 1, 0); PG8_STAGE(PG8_SA(0, 1), a2 + hstepA, voffA);
            PG8_WAIT_V(8); PG8_WAIT_L(0); PG8_BAR; PG8_MMA(0, 0, At, B0); PG8_MMA(0, 1, At, B1); PG8_BAR; PG8_SCHED;
            PG8_LDA(At, 1, 1); PG8_STAGE(PG8_SB(1, 0), b3, voffB); PG8_STAGE(PG8_SB(1, 1), b3 + hstepB, voffB); PG8_STAGE(PG8_SA(1, 0), a3, voffA);
            PG8_WAIT_V(8); PG8_WAIT_L(0); PG8_BAR; PG8_MMA(1, 0, At, B0); PG8_MMA(1, 1, At, B1); PG8_BAR; PG8_SCHED;
        }
        if constexpr (ALIGN_EPI) { if (wr == 0) PG8_BAR; }
        E(acc, cur, wr, wc, fr, fq);
        if (!has_next) break;
#pragma unroll
        for (int a = 0; a < 2; ++a)
#pragma unroll
            for (int b = 0; b < 2; ++b)
#pragma unroll
                for (int m = 0; m < 4; ++m)
#pragma unroll
                    for (int n = 0; n < 2; ++n) acc[a][b][m][n] = (f32x4){0.f, 0.f, 0.f, 0.f};
        cur = nxt; cA = nA; cB = nB; ++ui;
        if constexpr (ALIGN_EPI) { if (wr == 1) PG8_BAR; }
    }
    PG8_WAIT_V(0);
    if constexpr (!ALIGN_EPI) { if (wr == 0) PG8_BAR; }
    PG8_BAR;
#undef PG8_SA
#undef PG8_SB
#undef PG8_STAGE
#undef PG8_LDA
#undef PG8_LDB
#undef PG8_MMA
#undef PG8_WAIT_V
#undef PG8_WAIT_L
#undef PG8_BAR
#undef PG8_SCHED
}

typedef const f32x4 (&AccRef)[2][2][4][2];

struct EpiInProj {
    static constexpr bool PERM = true;
    bf16_t* H; const f32x2* rope64; const f32x2* rope32;
    __device__ __forceinline__ void operator()(AccRef acc, const Unit& u, int wr, int wc, int fr, int fq) const {
        const int pn = u.pn;
#pragma unroll
        for (int bj = 0; bj < 2; ++bj) {
            const int c0 = pn * BM + bj * HALF + wc * 32 + 8 * fq;
            int mode; float sc = 1.0f;
            if (pn < 4) { mode = 1; if (pn >= 2) sc = 0.08838834764831845f; }
            else if (pn == 8 || pn == 9) { mode = 2; sc = 0.125f; }
            else if (pn == 10 && bj == 0) { mode = 2; }
            else mode = 0;
#pragma unroll
            for (int ai = 0; ai < 2; ++ai)
#pragma unroll
                for (int m = 0; m < 4; ++m) {
                    const int row = u.pm * BM + ai * HALF + wr * 64 + m * 16 + fr;
                    f32x4 v0 = acc[ai][bj][m][0], v1 = acc[ai][bj][m][1];
                    if (mode != 0) {
                        const int s = row & (SEQ - 1);
                        const f32x4* tp = (mode == 1) ? (const f32x4*)(rope64 + (size_t)s * 64 + ((c0 & 127) >> 1)) : (const f32x4*)(rope32 + (size_t)s * 32 + ((c0 & 63) >> 1));
                        const f32x4 t0 = tp[0], t1 = tp[1];
                        f32x4 o0, o1;
                        o0[0] = v0[0] * t0[0] - v0[1] * t0[1]; o0[1] = v0[0] * t0[1] + v0[1] * t0[0];
                        o0[2] = v0[2] * t0[2] - v0[3] * t0[3]; o0[3] = v0[2] * t0[3] + v0[3] * t0[2];
                        o1[0] = v1[0] * t1[0] - v1[1] * t1[1]; o1[1] = v1[0] * t1[1] + v1[1] * t1[0];
                        o1[2] = v1[2] * t1[2] - v1[3] * t1[3]; o1[3] = v1[2] * t1[3] + v1[3] * t1[2];
                        v0 = o0 * sc; v1 = o1 * sc;
                    }
                    u32x4 w; w.x = cvt_pk_bf16(v0[0], v0[1]); w.y = cvt_pk_bf16(v0[2], v0[3]); w.z = cvt_pk_bf16(v1[0], v1[1]); w.w = cvt_pk_bf16(v1[2], v1[3]);
                    *(u32x4*)(H + (size_t)row * IN_EVEN + c0) = w;
                }
        }
    }
};
struct EpiResid {
    static constexpr bool PERM = false;
    const bf16_t* XB; float* Y;
    __device__ __forceinline__ void operator()(AccRef acc, const Unit& u, int wr, int wc, int fr, int fq) const {
#pragma unroll
        for (int ai = 0; ai < 2; ++ai)
#pragma unroll
            for (int m = 0; m < 4; ++m) {
                const size_t row = (size_t)(u.pm * BM + ai * HALF + wr * 64 + m * 16 + fr);
#pragma unroll
                for (int bj = 0; bj < 2; ++bj)
#pragma unroll
                    for (int n = 0; n < 2; ++n) {
                        const int c = u.pn * BM + bj * HALF + wc * 32 + n * 16 + 4 * fq;
                        const u32x2 xb = *(const u32x2*)(XB + row * DM + c);
                        f32x4 o = acc[ai][bj][m][n];
                        o[0] += ALPHA * bf_lo(xb.x); o[1] += ALPHA * bf_hi(xb.x); o[2] += ALPHA * bf_lo(xb.y); o[3] += ALPHA * bf_hi(xb.y);
                        *(f32x4*)(Y + row * DM + c) = o;
                    }
            }
    }
};
struct EpiGateUp {
    static constexpr bool PERM = true;
    bf16_t* HID;
    __device__ __forceinline__ void operator()(AccRef acc, const Unit& u, int wr, int wc, int fr, int fq) const {
#pragma unroll
        for (int ai = 0; ai < 2; ++ai)
#pragma unroll
            for (int m = 0; m < 4; ++m) {
                const size_t row = (size_t)(u.pm * BM + ai * HALF + wr * 64 + m * 16 + fr);
#pragma unroll
                for (int bj = 0; bj < 2; ++bj) {
                    const int c0 = u.pn * BM + bj * HALF + wc * 32 + 8 * fq;
                    const f32x4 v0 = acc[ai][bj][m][0], v1 = acc[ai][bj][m][1];
                    u32x2 w; w.x = cvt_pk_bf16(silu_f(v0[0]) * v0[1], silu_f(v0[2]) * v0[3]); w.y = cvt_pk_bf16(silu_f(v1[0]) * v1[1], silu_f(v1[2]) * v1[3]);
                    *(u32x2*)(HID + row * EH + (c0 >> 1)) = w;
                }
            }
    }
};
struct EpiDown {
    static constexpr bool PERM = true;
    bf16_t* YS; const float* gate;
    __device__ __forceinline__ void operator()(AccRef acc, const Unit& u, int wr, int wc, int fr, int fq) const {
#pragma unroll
        for (int ai = 0; ai < 2; ++ai)
#pragma unroll
            for (int m = 0; m < 4; ++m) {
                const size_t row = (size_t)(u.pm * BM + ai * HALF + wr * 64 + m * 16 + fr);
                const float g = gate[row];
#pragma unroll
                for (int bj = 0; bj < 2; ++bj) {
                    const int c0 = u.pn * BM + bj * HALF + wc * 32 + 8 * fq;
                    const f32x4 v0 = acc[ai][bj][m][0] * g, v1 = acc[ai][bj][m][1] * g;
                    u32x4 w; w.x = cvt_pk_bf16(v0[0], v0[1]); w.y = cvt_pk_bf16(v0[2], v0[3]); w.z = cvt_pk_bf16(v1[0], v1[1]); w.w = cvt_pk_bf16(v1[2], v1[3]);
                    *(u32x4*)(YS + row * DM + c0) = w;
                }
            }
    }
};
struct EpiWpp {
    static constexpr bool PERM = true;
    bf16_t* WPP;
    __device__ __forceinline__ void operator()(AccRef acc, const Unit& u, int wr, int wc, int fr, int fq) const {
        const int o = u.tag >> 2, g = u.tag & 3;
        bf16_t* base = WPP + (size_t)o * 1024 * 2048 + u.pn * 1024 + g * 256;
#pragma unroll
        for (int ai = 0; ai < 2; ++ai)
#pragma unroll
            for (int m = 0; m < 4; ++m) {
                const size_t row = (size_t)(u.pm * BM + ai * HALF + wr * 64 + m * 16 + fr);
#pragma unroll
                for (int bj = 0; bj < 2; ++bj) {
                    const int c0 = bj * HALF + wc * 32 + 8 * fq;
                    const f32x4 v0 = acc[ai][bj][m][0], v1 = acc[ai][bj][m][1];
                    u32x4 w; w.x = cvt_pk_bf16(v0[0], v0[1]); w.y = cvt_pk_bf16(v0[2], v0[3]); w.z = cvt_pk_bf16(v1[0], v1[1]); w.w = cvt_pk_bf16(v1[2], v1[3]);
                    *(u32x4*)(base + row * 2048 + c0) = w;
                }
            }
    }
};
struct WppOrder {
    const char* WFO; const char* CH; int G, c;
    __device__ __forceinline__ bool next(int i, Unit& u) const {
        const int L = i * G + c; if (L >= 64) return false;
        const int o = L >> 5, g = (L >> 3) & 3, pm = (L >> 1) & 3, pn = L & 1;
        u.pm = pm; u.pn = pn; u.tag = (o << 2) | g; u.pad = 0;
        u.a = WFO + (size_t)o * 1024 * 1024 * 2 + (size_t)pm * BM * 1024 * 2 + (size_t)g * 256 * 2;
        u.b = CH + (size_t)pn * BM * 256 * 2; return true;
    }
};
}

__device__ __forceinline__ bf16x8 frag_row(ldsp base, int rs, int r0, int k0, int lane) {
    return *(const LAS bf16x8*)(base + (r0 + (lane & 15)) * rs + (k0 + 8 * (lane >> 4)) * 2);
}
__device__ __forceinline__ unsigned tr_lane_base(unsigned base_u32, int rs, int lane) {
    const int g = lane >> 4, q = (lane & 15) >> 2, p = lane & 3;
    return base_u32 + (unsigned)((8 * g + q) * rs + 8 * p);
}
__device__ __forceinline__ bf16x8 frag_tr(unsigned lane_base, const int rs, const int k0, const int n0, int  ) {
    bf16x4 r0, r1;
    asm volatile("ds_read_b64_tr_b16 %0, %2 offset:%3\n\tds_read_b64_tr_b16 %1, %2 offset:%4\n\ts_waitcnt lgkmcnt(0)" : "=&v"(r0), "=&v"(r1) : "v"(lane_base), "i"(k0 * rs + n0 * 2), "i"(k0 * rs + n0 * 2 + 4 * rs) : "memory");
    bf16x8 r; r[0] = r0[0]; r[1] = r0[1]; r[2] = r0[2]; r[3] = r0[3]; r[4] = r1[0]; r[5] = r1[1]; r[6] = r1[2]; r[7] = r1[3];
    return r;
}
#define MFMA16(a, b, c) __builtin_amdgcn_mfma_f32_16x16x32_bf16((a), (b), (c), 0, 0, 0)

template <int ROWS, int CPR>
__device__ __forceinline__ void stage_tile(ldsp dst, int rs, const unsigned char* src, size_t gs, int tid) {
#pragma unroll
    for (int c = tid; c < ROWS * CPR; c += 512) { const int r = c / CPR, ch = c % CPR; const u32x4 v = *(const u32x4*)(src + (size_t)r * gs + ch * 16); *(LAS u32x4*)(dst + r * rs + ch * 16) = v; }
}

struct Args { const float* in[18]; float* out; unsigned char* ws; int ph_lo, ph_hi; };
enum { I_X = 0, I_WIN, I_DECAY, I_GN, I_SINK, I_WOUT, I_WFO, I_LN1G, I_LN1B, I_LN2G, I_LN2B, I_RCW, I_RCB, I_RFW, I_RFB, I_EWG, I_EWU, I_EWD };

struct Frame { ldsp lds; unsigned lds_u32; int tid, lane, wave, vcu, G; unsigned char* ws; };

template <int MAP>
__device__ __forceinline__ void p0_transpose_item(const float* W, int K, int N, bf16_t* WT, LAS float* scr, int item, int lane) {
    const int nblk = N / 32, kb = item / nblk, nb = item % nblk, k0 = 64 * kb, n0 = 32 * nb;
#pragma unroll 8
    for (int i = 0; i < 32; ++i) { const int kk = 2 * i + (lane >> 5); scr[kk * 33 + (lane & 31)] = W[(size_t)(k0 + kk) * N + n0 + (lane & 31)]; }
    asm volatile("s_waitcnt lgkmcnt(0)" ::: "memory");
    const int c = lane & 7;
#pragma unroll
    for (int j = 0; j < 4; ++j) { const int n = (lane >> 3) + 8 * j; const LAS float* s = scr + (8 * c) * 33 + n;
        u32x4 o; o.x = pk2(s[0 * 33], s[1 * 33]); o.y = pk2(s[2 * 33], s[3 * 33]); o.z = pk2(s[4 * 33], s[5 * 33]); o.w = pk2(s[6 * 33], s[7 * 33]);
        int nn = n0 + n;
        if (MAP == 1) {
            if (nn < 1024) { const int hd = nn >> 7, jj = nn & 127; nn = hd * 128 + 2 * (jj & 63) + (jj >> 6); }
            else if (nn >= C_QB && nn < C_VB) { const int mm = nn - C_QB, hd = mm >> 6, jj = mm & 63; nn = C_QB + hd * 64 + 2 * (jj & 31) + (jj >> 5); }
        } else if (MAP == 2) nn = 2 * nn; else if (MAP == 3) nn = 2 * nn + 1;
        *(u32x4*)(WT + (size_t)nn * K + k0 + 8 * c) = o; }
    asm volatile("s_waitcnt lgkmcnt(0)" ::: "memory");
}
__device__ __forceinline__ void p0a_prologue(const Frame& F, const Args& a) {
    LAS float* scr = (LAS float*)(F.lds + F.wave * 16384);
    const int gw = F.vcu * 8 + F.wave, NGW = F.G * 8;
    unsigned char* ws = F.ws;
    constexpr int I_IN = 16 * 88, I_SQ = 16 * 32, I_GU = 16 * 16, I_DN = 8 * 32;
    constexpr int N0 = 2 * I_IN, N1 = N0 + 2 * I_SQ, N2 = N1 + 2 * I_SQ, N3 = N2 + 128 * I_GU, N4 = N3 + 128 * I_GU, N5 = N4 + 128 * I_DN;
    for (int it = gw; it < N5; it += NGW) {
        if (it < N0) { const int e = it / I_IN, r = it % I_IN; p0_transpose_item<1>(a.in[I_WIN] + (size_t)e * 1024 * IN_EVEN, 1024, IN_EVEN, (bf16_t*)(ws + WS_WIN) + (size_t)e * IN_EVEN * 1024, scr, r, F.lane); }
        else if (it < N1) { const int q = it - N0, e = q / I_SQ, r = q % I_SQ; p0_transpose_item<0>(a.in[I_WOUT] + (size_t)e * 1024 * 1024, 1024, 1024, (bf16_t*)(ws + WS_WOUT) + (size_t)e * 1024 * 1024, scr, r, F.lane); }
        else if (it < N2) { const int q = it - N1, e = q / I_SQ, r = q % I_SQ; p0_transpose_item<0>(a.in[I_WFO] + (size_t)e * 1024 * 1024, 1024, 1024, (bf16_t*)(ws + WS_WFO) + (size_t)e * 1024 * 1024, scr, r, F.lane); }
        else if (it < N3) { const int q = it - N2, e = q / I_GU, r = q % I_GU; p0_transpose_item<2>(a.in[I_EWG] + (size_t)e * 1024 * EH, 1024, EH, (bf16_t*)(ws + WS_WGU) + (size_t)e * 1024 * 1024, scr, r, F.lane); }
        else if (it < N4) { const int q = it - N3, e = q / I_GU, r = q % I_GU; p0_transpose_item<3>(a.in[I_EWU] + (size_t)e * 1024 * EH, 1024, EH, (bf16_t*)(ws + WS_WGU) + (size_t)e * 1024 * 1024, scr, r, F.lane); }
        else { const int q = it - N4, e = q / I_DN, r = q % I_DN; p0_transpose_item<0>(a.in[I_EWD] + (size_t)e * EH * 1024, EH, 1024, (bf16_t*)(ws + WS_WD) + (size_t)e * 1024 * EH, scr, r, F.lane); }
    }
    const int gt = F.vcu * 512 + F.tid, NGT = F.G * 512;
    {
        f32x2* r64 = (f32x2*)(ws + WS_ROPE64); f32x2* r32 = (f32x2*)(ws + WS_ROPE32);
        for (int idx = gt; idx < SEQ * 96; idx += NGT) {
            const int s = idx / 96, i = idx % 96; const bool big = i < 64; const int ii = big ? i : i - 64;
            const double base = big ? 0.8659643233600653 : 0.7498942093324558;
            double inv = 1.0; for (int k = 0; k < ii; ++k) inv *= base;
            const double turns = (double)s * inv * 0.15915494309189535;
            const double fr = turns - __builtin_rint(turns);
            double sn, cs; sincos_turn(fr, sn, cs);
            const f32x2 v = {(float)cs, (float)sn};
            if (big) r64[(size_t)s * 64 + ii] = v; else r32[(size_t)s * 32 + ii] = v;
        }
    }
    {
        bf16_t* t1 = (bf16_t*)(ws + WS_FFT1);
        for (int idx = gt; idx < 64 * 128 * 64; idx += NGT) {
            const int n2 = idx >> 13, row = (idx >> 6) & 127, n1 = idx & 63, k1 = row & 63;
            double sn, cs; sincos_frac(k1 * (64 * n1 + n2), 4096, sn, cs);
            t1[idx] = (bf16_t)f2bf((float)((row < 64 ? cs : -sn) * (1.0 / 64.0)));
        }
        bf16_t* t2 = (bf16_t*)(ws + WS_FFT2);
        for (int idx = gt; idx < 128 * 128; idx += NGT) {
            const int r = idx >> 7, c = idx & 127, k2 = r & 63, n2 = c & 63, ri = r >> 6, rj = c >> 6;
            double sn, cs; sincos_frac(k2 * n2, 64, sn, cs);
            const double v = (ri == rj) ? cs : (ri == 0 ? sn : -sn);
            t2[idx] = (bf16_t)f2bf((float)v);
        }
        bf16_t* t3 = (bf16_t*)(ws + WS_CHDFT);
        for (int idx = gt; idx < 512 * 256; idx += NGT) {
            const int r = idx >> 8, cp = idx & 255, c = r & 255, ri = r >> 8;
            double sn, cs; sincos_frac(c * cp, 256, sn, cs);
            t3[idx] = (bf16_t)f2bf((float)((ri == 0 ? cs : sn) * (1.0 / 16.0)));
        }
        float* wr = (float*)(ws + WS_WRT);
        for (int idx = gt; idx < DEPTH * 36 * 1024; idx += NGT) {
            const int L = idx / (36 * 1024), o = (idx / 1024) % 36, k = idx & 1023;
            wr[idx] = (o < 4) ? a.in[I_RCW][((size_t)L * 1024 + k) * 4 + o] : a.in[I_RFW][((size_t)L * 1024 + k) * 32 + (o - 4)];
        }
    }
    {
        const f32x4* x4 = (const f32x4*)a.in[I_X]; u32x2* xb = (u32x2*)(ws + WS_XB);
        for (size_t idx = gt; idx < (size_t)NT * DM / 4; idx += NGT) { const f32x4 v = x4[idx]; u32x2 o; o.x = pk2(v[0], v[1]); o.y = pk2(v[2], v[3]); xb[idx] = o; }
    }
}

__device__ __forceinline__ float log2_sigmoid(float z) { return -__log2f(1.0f + __expf(-z)); }
constexpr int RS128 = 272;
__device__ __forceinline__ void a2_ret_states(const Frame& F, const float* decay  ) {
    const bf16_t* H = (const bf16_t*)(F.ws + WS_SCR + SC_H);
    float* KV = (float*)(F.ws + WS_SCR + SC_KV);
    const ldsp Vt = F.lds, Kf = F.lds + 128 * RS128, Kb = F.lds + 2 * 128 * RS128;
    const unsigned uV = tr_lane_base(F.lds_u32, RS128, F.lane), uKf = uV + 128 * RS128, uKb = uV + 2 * 128 * RS128;
    const int lane = F.lane, w = F.wave;
    for (int u = F.vcu; u < 1024; u += F.G) {
        const int b = u >> 7, hh = (u >> 5) & 3, n = u & 31;
        const size_t t0 = (size_t)b * SEQ + n * 128;
        const float lgf = log2_sigmoid(decay[hh]), lgb = log2_sigmoid(decay[4 + hh]);
        __syncthreads();
#pragma unroll
        for (int c = F.tid; c < 128 * 16; c += 512) {
            const int r = c >> 4, ch = c & 15;
            const u32x4 vv = *(const u32x4*)(H + (t0 + r) * IN_EVEN + C_VA + hh * 128 + ch * 8);
            *(LAS u32x4*)(Vt + r * RS128 + ch * 16) = vv;
            const u32x4 kk = *(const u32x4*)(H + (t0 + r) * IN_EVEN + C_KA + hh * 128 + ch * 8);
            const float zf = exp2f(lgf * (float)(127 - r)), zb = exp2f(lgb * (float)r);
            u32x4 of, ob;
            of.x = pk2(bf_lo(kk.x) * zf, bf_hi(kk.x) * zf); of.y = pk2(bf_lo(kk.y) * zf, bf_hi(kk.y) * zf); of.z = pk2(bf_lo(kk.z) * zf, bf_hi(kk.z) * zf); of.w = pk2(bf_lo(kk.w) * zf, bf_hi(kk.w) * zf);
            ob.x = pk2(bf_lo(kk.x) * zb, bf_hi(kk.x) * zb); ob.y = pk2(bf_lo(kk.y) * zb, bf_hi(kk.y) * zb); ob.z = pk2(bf_lo(kk.z) * zb, bf_hi(kk.z) * zb); ob.w = pk2(bf_lo(kk.w) * zb, bf_hi(kk.w) * zb);
            *(LAS u32x4*)(Kf + r * RS128 + ch * 16) = of;
            *(LAS u32x4*)(Kb + r * RS128 + ch * 16) = ob;
        }
        __syncthreads();
        f32x4 af[8], ab[8];
#pragma unroll
        for (int i = 0; i < 8; ++i) { af[i] = (f32x4){0.f, 0.f, 0.f, 0.f}; ab[i] = (f32x4){0.f, 0.f, 0.f, 0.f}; }
#pragma unroll
        for (int ks = 0; ks < 4; ++ks) {
            const bf16x8 a = frag_tr(uV + 32 * w, RS128, 32 * ks, 0, lane);
#pragma unroll
            for (int nt = 0; nt < 8; ++nt) {
                const bf16x8 bf = frag_tr(uKf, RS128, 32 * ks, 16 * nt, lane);
                af[nt] = MFMA16(a, bf, af[nt]);
                const bf16x8 bb = frag_tr(uKb, RS128, 32 * ks, 16 * nt, lane);
                ab[nt] = MFMA16(a, bb, ab[nt]);
            }
        }
        float* of = KV + (size_t)u * 2 * 16384; float* ob = of + 16384;
#pragma unroll
        for (int nt = 0; nt < 8; ++nt)
#pragma unroll
            for (int i = 0; i < 4; ++i) {
                const int dv = 16 * w + 4 * (lane >> 4) + i, dk = 16 * nt + (lane & 15);
                of[dv * 128 + dk] = af[nt][i]; ob[dv * 128 + dk] = ab[nt][i];
            }
    }
}
__device__ __forceinline__ void a3_ret_scan(const Frame& F, const float* decay) {
    const float* KV = (const float*)(F.ws + WS_SCR + SC_KV);
    bf16_t* RT = (bf16_t*)(F.ws + WS_SCR + SC_RT);
    for (int it = F.vcu * 512 + F.tid; it < 32 * 2 * 2048; it += F.G * 512) {
        const int bh = it >> 12, dir = (it >> 11) & 1, e8 = (it & 2047) * 8, hh = bh & 3;
        const float cd = exp2f(128.0f * log2_sigmoid(decay[dir * 4 + hh]));
        f32x4 s0 = {0.f, 0.f, 0.f, 0.f}, s1 = {0.f, 0.f, 0.f, 0.f};
        for (int k = 0; k < 32; ++k) {
            const int n = dir ? 31 - k : k;
            const size_t off = ((size_t)(bh * 32 + n) * 2 + dir) * 16384 + e8;
            u32x4 o; o.x = pk2(s0[0], s0[1]); o.y = pk2(s0[2], s0[3]); o.z = pk2(s1[0], s1[1]); o.w = pk2(s1[2], s1[3]);
            *(u32x4*)(RT + off) = o;
            const f32x4 k0 = *(const f32x4*)(KV + off), k1 = *(const f32x4*)(KV + off + 4);
            s0 = s0 * cd + k0; s1 = s1 * cd + k1;
        }
    }
}
__device__ __forceinline__ void a4_ret_unit(const Frame& F, int u, const float* decay, const float* gn_gain) {
    const bf16_t* H = (const bf16_t*)(F.ws + WS_SCR + SC_H);
    const bf16_t* RT = (const bf16_t*)(F.ws + WS_SCR + SC_RT);
    bf16_t* YC = (bf16_t*)(F.ws + WS_SCR + SC_YCAT);
    const ldsp Qs = F.lds, Ks = F.lds + 128 * RS128, Vs = F.lds + 2 * 128 * RS128, Ps = F.lds + 3 * 128 * RS128;
    const unsigned uVs = tr_lane_base(F.lds_u32 + 2 * 128 * RS128, RS128, F.lane);
    const int lane = F.lane, w = F.wave, g = lane >> 4, cl = lane & 15;
    const int b = u >> 7, hh = (u >> 5) & 3, n = u & 31;
    const size_t t0 = (size_t)b * SEQ + n * 128;
    const float lgf = log2_sigmoid(decay[hh]), lgb = log2_sigmoid(decay[4 + hh]);
    __syncthreads();
    stage_tile<128, 16>(Qs, RS128, (const unsigned char*)(H + t0 * IN_EVEN + C_QA + hh * 128), IN_EVEN * 2, F.tid);
    stage_tile<128, 16>(Ks, RS128, (const unsigned char*)(H + t0 * IN_EVEN + C_KA + hh * 128), IN_EVEN * 2, F.tid);
    stage_tile<128, 16>(Vs, RS128, (const unsigned char*)(H + t0 * IN_EVEN + C_VA + hh * 128), IN_EVEN * 2, F.tid);
    __syncthreads();
    f32x4 acc[8];
#pragma unroll
    for (int i = 0; i < 8; ++i) acc[i] = (f32x4){0.f, 0.f, 0.f, 0.f};
#pragma unroll
    for (int ks = 0; ks < 4; ++ks) {
        const bf16x8 a = frag_row(Qs, RS128, 16 * w, 32 * ks, lane);
#pragma unroll
        for (int nt = 0; nt < 8; ++nt) acc[nt] = MFMA16(a, frag_row(Ks, RS128, 16 * nt, 32 * ks, lane), acc[nt]);
    }
#pragma unroll
    for (int nt = 0; nt < 8; ++nt)
#pragma unroll
        for (int i = 0; i < 4; ++i) {
            const int ii = 16 * w + 4 * g + i, jj = 16 * nt + cl, d = ii - jj;
            const float dec = d >= 0 ? exp2f(lgf * (float)d) : exp2f(lgb * (float)(-d));
            *(LAS bf16_t*)(Ps + ii * RS128 + jj * 2) = (bf16_t)f2bf(acc[nt][i] * dec);
        }
    f32x4 y[8];
#pragma unroll
    for (int i = 0; i < 8; ++i) y[i] = (f32x4){0.f, 0.f, 0.f, 0.f};
#pragma unroll
    for (int ks = 0; ks < 4; ++ks) {
        const bf16x8 a = frag_row(Ps, RS128, 16 * w, 32 * ks, lane);
#pragma unroll
        for (int nt = 0; nt < 8; ++nt) y[nt] = MFMA16(a, frag_tr(uVs, RS128, 32 * ks, 16 * nt, lane), y[nt]);
    }
#pragma unroll 1
    for (int dir = 0; dir < 2; ++dir) {
        __syncthreads();
        stage_tile<128, 16>(Ks, RS128, (const unsigned char*)(RT + ((size_t)u * 2 + dir) * 16384), 256, F.tid);
        __syncthreads();
#pragma unroll
        for (int i = 0; i < 8; ++i) acc[i] = (f32x4){0.f, 0.f, 0.f, 0.f};
#pragma unroll
        for (int ks = 0; ks < 4; ++ks) {
            const bf16x8 a = frag_row(Qs, RS128, 16 * w, 32 * ks, lane);
#pragma unroll
            for (int nt = 0; nt < 8; ++nt) acc[nt] = MFMA16(a, frag_row(Ks, RS128, 16 * nt, 32 * ks, lane), acc[nt]);
        }
#pragma unroll
        for (int i = 0; i < 4; ++i) {
            const int il = 16 * w + 4 * g + i;
            const float xi = dir == 0 ? exp2f(lgf * (float)(il + 1)) : exp2f(lgb * (float)(128 - il));
#pragma unroll
            for (int nt = 0; nt < 8; ++nt) y[nt][i] += xi * acc[nt][i];
        }
    }
#pragma unroll
    for (int i = 0; i < 4; ++i) {
        float s = 0.f;
#pragma unroll
        for (int nt = 0; nt < 8; ++nt) s += y[nt][i];
        s += __shfl_xor(s, 1); s += __shfl_xor(s, 2); s += __shfl_xor(s, 4); s += __shfl_xor(s, 8);
        const float mu = s * (1.0f / 128.0f);
        float q = 0.f;
#pragma unroll
        for (int nt = 0; nt < 8; ++nt) { const float d = y[nt][i] - mu; q += d * d; }
        q += __shfl_xor(q, 1); q += __shfl_xor(q, 2); q += __shfl_xor(q, 4); q += __shfl_xor(q, 8);
        const float rstd = 1.0f / sqrtf(q * (1.0f / 128.0f) + GN_EPS);
        const size_t t = t0 + 16 * w + 4 * g + i;
#pragma unroll
        for (int nt = 0; nt < 8; ++nt) {
            const int dv = 16 * nt + cl;
            const float ga = bf2f(H[t * IN_EVEN + C_GA + hh * 128 + dv]);
            const float o = (y[nt][i] - mu) * rstd * gn_gain[hh * 128 + dv] * silu_f(ga);
            YC[t * DM + hh * 128 + dv] = (bf16_t)f2bf(o);
        }
    }
}
constexpr int RS64 = 144;
__device__ __forceinline__ void a4_win_unit(const Frame& F, int u, const float* sink) {
    const bf16_t* H = (const bf16_t*)(F.ws + WS_SCR + SC_H);
    bf16_t* YC = (bf16_t*)(F.ws + WS_SCR + SC_YCAT);
    const ldsp Ks = F.lds, Vs = F.lds + 384 * RS64, Pw = F.lds + 2 * 384 * RS64 + F.wave * (16 * RS128);
    const unsigned uVs = tr_lane_base(F.lds_u32 + 384 * RS64, RS64, F.lane);
    const int lane = F.lane, w = F.wave, g = lane >> 4, cl = lane & 15;
    const int b = u >> 6, kvh = (u >> 5) & 1, n = u & 31;
    const size_t tb = (size_t)b * SEQ;
    __syncthreads();
#pragma unroll
    for (int c = F.tid; c < 384 * 8; c += 512) {
        const int r = c >> 3, ch = c & 7, kp = n * 128 - 128 + r;
        u32x4 kk = {0u, 0u, 0u, 0u}, vv = {0u, 0u, 0u, 0u};
        if (kp >= 0 && kp < SEQ) {
            kk = *(const u32x4*)(H + (tb + kp) * IN_EVEN + C_KB + kvh * 64 + ch * 8);
            vv = *(const u32x4*)(H + (tb + kp) * IN_EVEN + C_VB + kvh * 64 + ch * 8);
        }
        *(LAS u32x4*)(Ks + r * RS64 + ch * 16) = kk;
        *(LAS u32x4*)(Vs + r * RS64 + ch * 16) = vv;
    }
    __syncthreads();
#pragma unroll 1
    for (int gq = 0; gq < 4; ++gq) {
        const int qh = kvh * 4 + gq;
        const float sk = sink[qh];
        const size_t tq = tb + n * 128 + 16 * w;
        bf16x8 qa[2];
#pragma unroll
        for (int ks = 0; ks < 2; ++ks) qa[ks] = *(const bf16x8*)(H + (tq + cl) * IN_EVEN + C_QB + qh * 64 + 32 * ks + 8 * g);
        const int dl0 = cl - (16 * w + 4 * g), kp0 = n * 128 - 128 + cl;
        float mx[4] = {sk, sk, sk, sk};
#pragma unroll 1
        for (int kb = 0; kb < 3; ++kb) {
            f32x4 s[8];
#pragma unroll
            for (int i = 0; i < 8; ++i) s[i] = (f32x4){0.f, 0.f, 0.f, 0.f};
            const ldsp Kb_ = Ks + kb * 128 * RS64;
#pragma unroll
            for (int ks = 0; ks < 2; ++ks)
#pragma unroll
                for (int nt = 0; nt < 8; ++nt) s[nt] = MFMA16(qa[ks], frag_row(Kb_, RS64, 16 * nt, 32 * ks, lane), s[nt]);
#pragma unroll
            for (int nt = 0; nt < 8; ++nt) {
                const int jb = kb * 128 + 16 * nt; const bool okk = (unsigned)(jb + kp0) < (unsigned)SEQ;
#pragma unroll
                for (int i = 0; i < 4; ++i) { const bool ok = okk && ((unsigned)(jb + dl0 - i) <= 256u); mx[i] = fmaxf(mx[i], ok ? s[nt][i] : -1e30f); }
            }
        }
#pragma unroll
        for (int i = 0; i < 4; ++i) { float m = mx[i]; m = fmaxf(m, __shfl_xor(m, 1)); m = fmaxf(m, __shfl_xor(m, 2)); m = fmaxf(m, __shfl_xor(m, 4)); m = fmaxf(m, __shfl_xor(m, 8)); mx[i] = m; }
        float sum[4] = {0.f, 0.f, 0.f, 0.f};
        f32x4 o[4];
#pragma unroll
        for (int i = 0; i < 4; ++i) o[i] = (f32x4){0.f, 0.f, 0.f, 0.f};
#pragma unroll 1
        for (int kb = 0; kb < 3; ++kb) {
            f32x4 s[8];
#pragma unroll
            for (int i = 0; i < 8; ++i) s[i] = (f32x4){0.f, 0.f, 0.f, 0.f};
            const ldsp Kb_ = Ks + kb * 128 * RS64;
#pragma unroll
            for (int ks = 0; ks < 2; ++ks)
#pragma unroll
                for (int nt = 0; nt < 8; ++nt) s[nt] = MFMA16(qa[ks], frag_row(Kb_, RS64, 16 * nt, 32 * ks, lane), s[nt]);
#pragma unroll
            for (int nt = 0; nt < 8; ++nt) {
                const int jb = kb * 128 + 16 * nt; const bool okk = (unsigned)(jb + kp0) < (unsigned)SEQ;
#pragma unroll
                for (int i = 0; i < 4; ++i) { const bool ok = okk && ((unsigned)(jb + dl0 - i) <= 256u);
                    const float p = ok ? __expf(s[nt][i] - mx[i]) : 0.f; sum[i] += p;
                    *(LAS bf16_t*)(Pw + (4 * g + i) * RS128 + (16 * nt + cl) * 2) = (bf16_t)f2bf(p); }
            }
            const unsigned uVb = uVs + (unsigned)(kb * 128 * RS64);
#pragma unroll
            for (int ks = 0; ks < 4; ++ks) {
                const bf16x8 a = frag_row(Pw, RS128, 0, 32 * ks, lane);
#pragma unroll
                for (int nt = 0; nt < 4; ++nt) o[nt] = MFMA16(a, frag_tr(uVb, RS64, 32 * ks, 16 * nt, lane), o[nt]);
            }
        }
#pragma unroll
        for (int i = 0; i < 4; ++i) { float sm = sum[i]; sm += __shfl_xor(sm, 1); sm += __shfl_xor(sm, 2); sm += __shfl_xor(sm, 4); sm += __shfl_xor(sm, 8);
            const float inv = 1.0f / (sm + __expf(sk - mx[i]));
#pragma unroll
            for (int nt = 0; nt < 4; ++nt) YC[(tq + 4 * g + i) * DM + 512 + qh * 64 + 16 * nt + cl] = (bf16_t)f2bf(o[nt][i] * inv); }
    }
}
constexpr int RS256 = 528;
__device__ __forceinline__ void b1_fft_stage1(const Frame& F) {
    const bf16_t* XB = (const bf16_t*)(F.ws + WS_XB);
    const bf16_t* TAB = (const bf16_t*)(F.ws + WS_FFT1);
    bf16_t* A1 = (bf16_t*)(F.ws + WS_SCR + SC_A1);
    const ldsp Ts = F.lds, Xs = F.lds + 128 * RS64;
    const unsigned uXs = tr_lane_base(F.lds_u32 + 128 * RS64, RS256, F.lane);
    const int lane = F.lane, w = F.wave, g = lane >> 4, cl = lane & 15;
    for (int u = F.vcu; u < 2048; u += F.G) {
        const int b = u >> 8, n2 = (u >> 2) & 63, cb = u & 3;
        __syncthreads();
        stage_tile<128, 8>(Ts, RS64, (const unsigned char*)(TAB + (size_t)n2 * 8192), 128, F.tid);
        stage_tile<64, 32>(Xs, RS256, (const unsigned char*)(XB + ((size_t)b * SEQ + n2) * DM + cb * 256), (size_t)64 * DM * 2, F.tid);
        __syncthreads();
        f32x4 acc[16];
#pragma unroll
        for (int i = 0; i < 16; ++i) acc[i] = (f32x4){0.f, 0.f, 0.f, 0.f};
#pragma unroll
        for (int ks = 0; ks < 2; ++ks) {
            const bf16x8 a = frag_row(Ts, RS64, 16 * w, 32 * ks, lane);
#pragma unroll
            for (int nt = 0; nt < 16; ++nt) acc[nt] = MFMA16(a, frag_tr(uXs, RS256, 32 * ks, 16 * nt, lane), acc[nt]);
        }
#pragma unroll
        for (int i = 0; i < 4; ++i) {
            const int r = 16 * w + 4 * g + i, ri = r >> 6, k1 = r & 63;
            bf16_t* dst = A1 + ((((size_t)b * 64 + k1) * 2 + ri) * 64 + n2) * DM + cb * 256;
#pragma unroll
            for (int nt = 0; nt < 16; ++nt) dst[16 * nt + cl] = (bf16_t)f2bf(acc[nt][i]);
        }
    }
}
__device__ __forceinline__ void b2_fft_stage2(const Frame& F) {
    const bf16_t* A1 = (const bf16_t*)(F.ws + WS_SCR + SC_A1);
    const bf16_t* GT = (const bf16_t*)(F.ws + WS_FFT2);
    bf16_t* V2 = (bf16_t*)(F.ws + WS_SCR + SC_V2);
    const ldsp Gs = F.lds, Xs = F.lds + 128 * RS128;
    const unsigned uXs = tr_lane_base(F.lds_u32 + 128 * RS128, RS256, F.lane);
    const int lane = F.lane, w = F.wave, g = lane >> 4, cl = lane & 15;
    for (int u = F.vcu; u < 2048; u += F.G) {
        const int b = u >> 8, k1 = (u >> 2) & 63, cb = u & 3;
        __syncthreads();
        stage_tile<128, 16>(Gs, RS128, (const unsigned char*)GT, 256, F.tid);
        stage_tile<128, 32>(Xs, RS256, (const unsigned char*)(A1 + ((size_t)b * 64 + k1) * 128 * DM + cb * 256), (size_t)DM * 2, F.tid);
        __syncthreads();
        f32x4 acc[16];
#pragma unroll
        for (int i = 0; i < 16; ++i) acc[i] = (f32x4){0.f, 0.f, 0.f, 0.f};
#pragma unroll
        for (int ks = 0; ks < 4; ++ks) {
            const bf16x8 a = frag_row(Gs, RS128, 16 * w, 32 * ks, lane);
#pragma unroll
            for (int nt = 0; nt < 16; ++nt) acc[nt] = MFMA16(a, frag_tr(uXs, RS256, 32 * ks, 16 * nt, lane), acc[nt]);
        }
#pragma unroll
        for (int i = 0; i < 4; ++i) {
            const int r = 16 * w + 4 * g + i, ri = r >> 6, k2 = r & 63;
            bf16_t* dst = V2 + ((size_t)b * SEQ + k1 + 64 * k2) * 2048 + ri * 1024 + cb * 256;
#pragma unroll
            for (int nt = 0; nt < 16; ++nt) dst[16 * nt + cl] = (bf16_t)f2bf(acc[nt][i]);
        }
    }
}
__device__ __forceinline__ void m1_ln_router(const Frame& F, const Args& a, int L) {
    const float* YP = (const float*)(F.ws + WS_SCR + SC_YPRE);
    bf16_t* X1 = (bf16_t*)(F.ws + WS_X1B);
    const float* WR = (const float*)(F.ws + WS_WRT) + (size_t)L * 36 * 1024;
    const float* gain = a.in[I_LN1G] + L * DM; const float* bias = a.in[I_LN1B] + L * DM;
    const float* cb = a.in[I_RCB] + L * 4; const float* fb = a.in[I_RFB] + L * 32;
    int* TOKE = (int*)(F.ws + WS_ROUTE + RT_TOKE); float* TOKG = (float*)(F.ws + WS_ROUTE + RT_TOKG); int* TOKR = (int*)(F.ws + WS_ROUTE + RT_TOKR);
    int* BCNT = (int*)(F.ws + WS_ROUTE + RT_BCNT);
    LAS float* part = (LAS float*)(F.lds + F.wave * (64 * 37 * 4));
    LAS float* lg = (LAS float*)(F.lds + 8 * 64 * 37 * 4 + F.wave * 256);
    LAS int* se = (LAS int*)(F.lds + 8 * 64 * 37 * 4 + 8 * 256);
    LAS float* sg = (LAS float*)(se + 256);
    LAS int* sr = (LAS int*)(sg + 256);
    const int lane = F.lane;
    f32x4 gn[4], bs[4];
#pragma unroll
    for (int j = 0; j < 4; ++j) { gn[j] = *(const f32x4*)(gain + 4 * lane + 256 * j); bs[j] = *(const f32x4*)(bias + 4 * lane + 256 * j); }
    for (int blk = F.vcu; blk < NT / 128; blk += F.G) {
        __syncthreads();
#pragma unroll 1
        for (int tt = 0; tt < 16; ++tt) {
            const int tl = F.wave * 16 + tt; const size_t t = (size_t)blk * 128 + tl;
            f32x4 v[4]; float s = 0.f;
#pragma unroll
            for (int j = 0; j < 4; ++j) { v[j] = *(const f32x4*)(YP + t * DM + 4 * lane + 256 * j); s += (v[j][0] + v[j][1]) + (v[j][2] + v[j][3]); }
            const float mean = wave_sum(s) * (1.0f / DM); float q = 0.f;
#pragma unroll
            for (int j = 0; j < 4; ++j) { v[j] = v[j] - mean; q += (v[j][0] * v[j][0] + v[j][1] * v[j][1]) + (v[j][2] * v[j][2] + v[j][3] * v[j][3]); }
            const float rstd = 1.0f / sqrtf(wave_sum(q) * (1.0f / DM) + LN_EPS);
#pragma unroll
            for (int j = 0; j < 4; ++j) { v[j] = v[j] * rstd * gn[j] + bs[j]; u32x2 o; o.x = pk2(v[j][0], v[j][1]); o.y = pk2(v[j][2], v[j][3]); *(u32x2*)(X1 + t * DM + 4 * lane + 256 * j) = o; }
#pragma unroll 4
            for (int o = 0; o < 36; ++o) {
                float p = 0.f;
#pragma unroll
                for (int j = 0; j < 4; ++j) { const f32x4 wv = *(const f32x4*)(WR + o * 1024 + 4 * lane + 256 * j); p += (v[j][0] * wv[0] + v[j][1] * wv[1]) + (v[j][2] * wv[2] + v[j][3] * wv[3]); }
                part[lane * 37 + o] = p;
            }
            if (lane < 36) {
                float sum = 0.f;
#pragma unroll 8
                for (int l2 = 0; l2 < 64; ++l2) sum += part[l2 * 37 + lane];
                lg[lane] = sum + (lane < 4 ? cb[lane] : fb[lane - 4]);
            }
            if (lane == 0) {
                float c0 = lg[0]; int gi = 0;
#pragma unroll
                for (int k = 1; k < 4; ++k) { const float c = lg[k]; if (c > c0) { c0 = c; gi = k; } }
                float den = 0.f;
#pragma unroll
                for (int k = 0; k < 4; ++k) den += __expf(lg[k] - c0);
                const float pg = 1.0f / den;
                float v1 = -3.0e38f, v2 = -3.0e38f; int i1 = 0, i2 = 0;
                for (int k = 0; k < 8; ++k) { const float f = lg[4 + gi * 8 + k];
                    if (f > v1) { v2 = v1; i2 = i1; v1 = f; i1 = k; } else if (f > v2) { v2 = f; i2 = k; } }
                const float e2 = __expf(v2 - v1), g1 = pg / (1.0f + e2), g2 = pg * e2 / (1.0f + e2);
                se[2 * tl] = gi * 8 + i1; se[2 * tl + 1] = gi * 8 + i2; sg[2 * tl] = g1; sg[2 * tl + 1] = g2;
            }
        }
        __syncthreads();
        LAS int* cn = sr + 256;
        if (F.tid < 32) cn[F.tid] = 0;
        __syncthreads();
        if (F.tid == 0) { for (int i = 0; i < 256; ++i) { const int e = se[i]; const int r = cn[e]; sr[i] = r; cn[e] = r + 1; } }
        __syncthreads();
        if (F.tid < 256) { const size_t ai = (size_t)blk * 256 + F.tid; TOKE[ai] = se[F.tid]; TOKG[ai] = sg[F.tid]; TOKR[ai] = sr[F.tid]; }
        if (F.tid < 32) BCNT[blk * 32 + F.tid] = cn[F.tid];
    }
}
__device__ __forceinline__ void m2_scatter(const Frame& F) {
    const int* TOKE = (const int*)(F.ws + WS_ROUTE + RT_TOKE); const float* TOKG = (const float*)(F.ws + WS_ROUTE + RT_TOKG); const int* TOKR = (const int*)(F.ws + WS_ROUTE + RT_TOKR);
    int* TOKP = (int*)(F.ws + WS_ROUTE + RT_TOKP); const int* BCNT = (const int*)(F.ws + WS_ROUTE + RT_BCNT);
    float* SGATE = (float*)(F.ws + WS_ROUTE + RT_SGATE); int* TILEE = (int*)(F.ws + WS_ROUTE + RT_TILEE);
    const bf16_t* X1 = (const bf16_t*)(F.ws + WS_X1B); bf16_t* XS = (bf16_t*)(F.ws + WS_SCR + SC_XS);
    LAS int* pre = (LAS int*)F.lds; LAS int* tot = pre + 32; LAS int* start = tot + 32; LAS int* pos = start + 32;
    for (int blk = F.vcu; blk < NT / 128; blk += F.G) {
        __syncthreads();
        if (F.tid < 32) { int p = 0, tt = 0; for (int b2 = 0; b2 < NT / 128; ++b2) { const int c = BCNT[b2 * 32 + F.tid]; if (b2 < blk) p += c; tt += c; } pre[F.tid] = p; tot[F.tid] = tt; }
        __syncthreads();
        if (F.tid == 0) {
            int st = 0;
            for (int e = 0; e < 32; ++e) { start[e] = st; const int nt_e = (tot[e] + 255) >> 8;
                if (blk == 0) for (int k = 0; k < nt_e; ++k) TILEE[(st >> 8) + k] = e;
                st += nt_e << 8; }
            if (blk == 0) TILEE[320] = st >> 8;
        }
        __syncthreads();
        if (F.tid < 256) { const size_t ai = (size_t)blk * 256 + F.tid; const int e = TOKE[ai]; const int p = start[e] + pre[e] + TOKR[ai]; pos[F.tid] = p; TOKP[ai] = p; SGATE[p] = TOKG[ai]; }
        __syncthreads();
#pragma unroll 1
        for (int r = F.wave; r < 256; r += 8) {
            const size_t t = (size_t)blk * 128 + (r >> 1); const int p = pos[r];
            const u32x4* src = (const u32x4*)(X1 + t * DM); u32x4* dst = (u32x4*)(XS + (size_t)p * DM);
            dst[F.lane] = src[F.lane]; dst[F.lane + 64] = src[F.lane + 64];
        }
    }
}
__device__ __forceinline__ void m5_combine_ln(const Frame& F, const Args& a, int L) {
    const bf16_t* X1 = (const bf16_t*)(F.ws + WS_X1B); const bf16_t* YS = (const bf16_t*)(F.ws + WS_SCR + SC_YS);
    const int* TOKP = (const int*)(F.ws + WS_ROUTE + RT_TOKP);
    bf16_t* XB = (bf16_t*)(F.ws + WS_XB);
    const float* gain = a.in[I_LN2G] + L * DM; const float* bias = a.in[I_LN2B] + L * DM;
    const int lane = F.lane;
    f32x4 gn[4], bs[4];
#pragma unroll
    for (int j = 0; j < 4; ++j) { gn[j] = *(const f32x4*)(gain + 4 * lane + 256 * j); bs[j] = *(const f32x4*)(bias + 4 * lane + 256 * j); }
    for (int t = F.vcu * 8 + F.wave; t < NT; t += F.G * 8) {
        const int p0 = TOKP[2 * t], p1 = TOKP[2 * t + 1];
        f32x4 v[4]; float s = 0.f;
#pragma unroll
        for (int j = 0; j < 4; ++j) {
            const u32x2 x = *(const u32x2*)(X1 + (size_t)t * DM + 4 * lane + 256 * j);
            const u32x2 y0 = *(const u32x2*)(YS + (size_t)p0 * DM + 4 * lane + 256 * j);
            const u32x2 y1 = *(const u32x2*)(YS + (size_t)p1 * DM + 4 * lane + 256 * j);
            v[j][0] = ALPHA * bf_lo(x.x) + (bf_lo(y0.x) + bf_lo(y1.x)); v[j][1] = ALPHA * bf_hi(x.x) + (bf_hi(y0.x) + bf_hi(y1.x));
            v[j][2] = ALPHA * bf_lo(x.y) + (bf_lo(y0.y) + bf_lo(y1.y)); v[j][3] = ALPHA * bf_hi(x.y) + (bf_hi(y0.y) + bf_hi(y1.y));
            s += (v[j][0] + v[j][1]) + (v[j][2] + v[j][3]);
        }
        const float mean = wave_sum(s) * (1.0f / DM); float q = 0.f;
#pragma unroll
        for (int j = 0; j < 4; ++j) { v[j] = v[j] - mean; q += (v[j][0] * v[j][0] + v[j][1] * v[j][1]) + (v[j][2] * v[j][2] + v[j][3] * v[j][3]); }
        const float rstd = 1.0f / sqrtf(wave_sum(q) * (1.0f / DM) + LN_EPS);
#pragma unroll
        for (int j = 0; j < 4; ++j) {
            v[j] = v[j] * rstd * gn[j] + bs[j];
            u32x2 o; o.x = pk2(v[j][0], v[j][1]); o.y = pk2(v[j][2], v[j][3]); *(u32x2*)(XB + (size_t)t * DM + 4 * lane + 256 * j) = o;
            if (L == DEPTH - 1) *(f32x4*)(a.out + (size_t)t * DM + 4 * lane + 256 * j) = v[j];
        }
    }
}

__global__ void __launch_bounds__(512, 2) fwd_kernel(Args args) {
    extern __shared__ __attribute__((aligned(16))) unsigned char lds_raw[];
    Frame F;
    F.lds = (ldsp)lds_raw; F.lds_u32 = (unsigned)(size_t)lds_raw;
    F.tid = threadIdx.x; F.lane = F.tid & 63; F.wave = __builtin_amdgcn_readfirstlane(F.tid >> 6);
    F.G = gridDim.x; { const int bx = blockIdx.x; F.vcu = (F.G % 8 == 0) ? (bx % 8) * (F.G / 8) + bx / 8 : bx; }
    F.ws = args.ws;
    volatile LAS unsigned* MISC = (volatile LAS unsigned*)(F.lds + MISC_OFF);
    if (F.tid < 64) MISC[F.tid] = 0u;
    __syncthreads();
    XcdBarrier bar; bar.bar = (unsigned*)(args.ws + WS_CTL) + CW_BAR; bar.x = 0; bar.st = nullptr;
    const int lo = args.ph_lo, hi = args.ph_hi;
    if (hi - lo > 1) bar = xcd_barrier_post((unsigned*)(args.ws + WS_CTL) + CW_BAR, MISC + 8);
    int ph = 0;
#ifndef PH_MASK
#define PH_MASK 0xffffffffu
#endif
#define PH_BEGIN(id) if (((PH_MASK >> (id)) & 1u) && ph >= lo && ph < hi) { unsigned char* ws = args.ws; asm volatile("" : "+s"(ws)); Frame FL = F; FL.ws = ws; { int t_ = F.tid; asm volatile("" : "+v"(t_)); FL.tid = t_; FL.lane = t_ & 63; FL.wave = __builtin_amdgcn_readfirstlane(t_ >> 6); unsigned l_ = F.lds_u32; asm volatile("" : "+s"(l_)); FL.lds_u32 = l_; FL.lds = (ldsp)(uintptr_t)l_; }
#define PH_END   if (ph + 1 < hi) xcd_barrier(bar); } ++ph;
    const int bid = (int)blockIdx.x;

    PH_BEGIN(0) p0a_prologue(FL, args); PH_END
    PH_BEGIN(1) {
        pg8::WppOrder S{(const char*)(ws + WS_WFO), (const char*)(ws + WS_CHDFT), F.G, bid};
        pg8::EpiWpp E{(bf16_t*)(ws + WS_WPP)};
        pg8::gemm_phase<pg8::EpiWpp, pg8::WppOrder, true>(FL.lds, FL.tid, 1024, 256, 256, S, E);
    } PH_END

#pragma unroll 1
    for (int L = 0; L < DEPTH; ++L) {
        const int e = L >> 1;
        if ((L & 1) == 0) {
            PH_BEGIN(2) {
                pg8::DenseOrder S{(const char*)(ws + WS_XB), (const char*)(ws + WS_WIN) + (size_t)e * IN_EVEN * 1024 * 2, 1024, 1024, NT / 256, IN_EVEN / 256, F.G, bid};
                pg8::EpiInProj E{(bf16_t*)(ws + WS_SCR + SC_H), (const f32x2*)(ws + WS_ROPE64), (const f32x2*)(ws + WS_ROPE32)};
                pg8::gemm_phase<pg8::EpiInProj, pg8::DenseOrder, true>(FL.lds, FL.tid, 1024, 1024, 1024, S, E);
            } PH_END
            PH_BEGIN(3) a2_ret_states(FL, args.in[I_DECAY] + e * 8); PH_END
            PH_BEGIN(4) a3_ret_scan(FL, args.in[I_DECAY] + e * 8); PH_END
            PH_BEGIN(5) {
                for (int u = F.vcu; u < 1024; u += F.G) a4_ret_unit(FL, u, args.in[I_DECAY] + e * 8, args.in[I_GN] + e * 512);
                for (int u = F.vcu; u < 512; u += F.G) a4_win_unit(FL, u, args.in[I_SINK] + e * 8);
            } PH_END
            PH_BEGIN(6) {
                pg8::DenseOrder S{(const char*)(ws + WS_SCR + SC_YCAT), (const char*)(ws + WS_WOUT) + (size_t)e * 1024 * 1024 * 2, 1024, 1024, NT / 256, 4, F.G, bid};
                pg8::EpiResid E{(const bf16_t*)(ws + WS_XB), (float*)(ws + WS_SCR + SC_YPRE)};
                pg8::gemm_phase<pg8::EpiResid, pg8::DenseOrder, true>(FL.lds, FL.tid, 1024, 1024, 1024, S, E);
            } PH_END
        } else {
            PH_BEGIN(7) b1_fft_stage1(FL); PH_END
            PH_BEGIN(8) b2_fft_stage2(FL); PH_END
            PH_BEGIN(9) {
                pg8::DenseOrder S{(const char*)(ws + WS_SCR + SC_V2), (const char*)(ws + WS_WPP) + (size_t)e * 1024 * 2048 * 2, 2048, 2048, NT / 256, 4, F.G, bid};
                pg8::EpiResid E{(const bf16_t*)(ws + WS_XB), (float*)(ws + WS_SCR + SC_YPRE)};
                pg8::gemm_phase<pg8::EpiResid, pg8::DenseOrder, true>(FL.lds, FL.tid, 2048, 2048, 2048, S, E);
            } PH_END
        }
        PH_BEGIN(10) m1_ln_router(FL, args, L); PH_END
        PH_BEGIN(11) m2_scatter(FL); PH_END
        PH_BEGIN(12) {
            const int* tile_e = (const int*)(ws + WS_ROUTE + RT_TILEE);
            const int ntiles = __builtin_amdgcn_readfirstlane(tile_e[320]);
            pg8::GroupedOrder S{(const char*)(ws + WS_SCR + SC_XS), (const char*)(ws + WS_WGU) + (size_t)L * 32 * 1024 * 1024 * 2, tile_e, (size_t)1024 * 1024 * 2, 1024, 1024, ntiles, 4, F.G, bid};
            pg8::EpiGateUp E{(bf16_t*)(ws + WS_SCR + SC_HID)};
            pg8::gemm_phase<pg8::EpiGateUp, pg8::GroupedOrder, true>(FL.lds, FL.tid, 1024, 1024, 1024, S, E);
        } PH_END
        PH_BEGIN(13) {
            const int* tile_e = (const int*)(ws + WS_ROUTE + RT_TILEE);
            const int ntiles = __builtin_amdgcn_readfirstlane(tile_e[320]);
            pg8::GroupedOrder S{(const char*)(ws + WS_SCR + SC_HID), (const char*)(ws + WS_WD) + (size_t)L * 32 * 1024 * EH * 2, tile_e, (size_t)1024 * EH * 2, EH, EH, ntiles, 4, F.G, bid};
            pg8::EpiDown E{(bf16_t*)(ws + WS_SCR + SC_YS), (const float*)(ws + WS_ROUTE + RT_SGATE)};
            pg8::gemm_phase<pg8::EpiDown, pg8::GroupedOrder, true>(FL.lds, FL.tid, EH, EH, EH, S, E);
        } PH_END
        PH_BEGIN(14) m5_combine_ln(FL, args, L); PH_END
    }
#undef PH_BEGIN
#undef PH_END
}
constexpr int N_PHASES = 2 + 2 * 5 + 2 * 3 + 4 * 5;

extern "C" void kernel_launch(void* const* d_in, const int* in_sizes, int n_in, void* d_out, int out_size, void* d_ws, size_t ws_size, hipStream_t stream) {
    static int grid = 0;
    if (grid == 0) {
        if (n_in != 18 || out_size != NT * DM || ws_size < WS_END) { fprintf(stderr, "kernel_launch: unexpected shapes (n_in %d out %d ws %zu, need %zu)\n", n_in, out_size, ws_size, (size_t)WS_END); grid = -1; return; }
        int dev = 0, cus = 0, per_cu = 0;
        hipGetDevice(&dev); hipDeviceGetAttribute(&cus, hipDeviceAttributeMultiprocessorCount, dev);
        if (hipFuncSetAttribute((const void*)fwd_kernel, hipFuncAttributeMaxDynamicSharedMemorySize, LDS_BYTES) != hipSuccess) { fprintf(stderr, "kernel_launch: hipFuncSetAttribute failed\n"); grid = -1; return; }
        hipOccupancyMaxActiveBlocksPerMultiprocessor(&per_cu, (const void*)fwd_kernel, 512, LDS_BYTES);
        (void)hipGetLastError();
        if (per_cu < 1) fprintf(stderr, "kernel_launch: occupancy query says %d blocks/CU\n", per_cu);
        grid = cus > 0 ? cus : 256;
    }
    if (grid < 0) return;
    hipMemsetAsync((char*)d_ws + WS_CTL, 0, CTL_BYTES, stream);
    Args a{};
    for (int i = 0; i < 18; ++i) a.in[i] = (const float*)d_in[i];
    a.out = (float*)d_out; a.ws = (unsigned char*)d_ws;
#if N_LAUNCH_MODE == 1
    a.ph_lo = 0; a.ph_hi = N_PHASES;
    void* kargs[] = {&a};
    hipError_t le = hipLaunchCooperativeKernel((const void*)fwd_kernel, dim3(grid), dim3(512), kargs, LDS_BYTES, stream);
    if (le != hipSuccess) fprintf(stderr, "kernel_launch: cooperative launch failed: %s\n", hipGetErrorName(le));
#else
    for (int p = 0; p < N_PHASES; ++p) {
        a.ph_lo = p; a.ph_hi = p + 1;
        hipLaunchKernelGGL(fwd_kernel, dim3(grid), dim3(512), LDS_BYTES, stream, a);
    }
#endif
}
```

```cpp
#include <hip/hip_runtime.h>
#include <cstdio>
#include <cstdint>

#ifndef N_LAUNCH_MODE
#define N_LAUNCH_MODE 1
#endif

#define LAS __attribute__((address_space(3)))
typedef unsigned short bf16_t;
typedef short bf16x8 __attribute__((ext_vector_type(8)));
typedef short bf16x4 __attribute__((ext_vector_type(4)));
typedef float f32x4 __attribute__((ext_vector_type(4)));
typedef float f32x2 __attribute__((ext_vector_type(2)));
typedef unsigned u32x4 __attribute__((ext_vector_type(4)));
typedef unsigned u32x2 __attribute__((ext_vector_type(2)));
typedef LAS unsigned char* ldsp;

constexpr int NB = 8, SEQ = 4096, DM = 1024, NT = NB * SEQ, DEPTH = 4;
constexpr int IN_EVEN = 2816;
constexpr int C_QA = 0, C_KA = 512, C_VA = 1024, C_GA = 1536, C_QB = 2048, C_KB = 2560, C_VB = 2688;
constexpr int NEXP = 32, EH = 512;
constexpr int RMAX = 65536 + 32 * 256;
constexpr float LN_EPS = 1e-5f, GN_EPS = 1e-6f;
constexpr float ALPHA = 1.681792830507429f;

constexpr size_t MiB = 1u << 20;
constexpr size_t WS_CTL = 0, CTL_BYTES = 1 * MiB;
constexpr size_t WS_ROPE64 = 1 * MiB;
constexpr size_t WS_ROPE32 = 3 * MiB;
constexpr size_t WS_FFT1 = 4 * MiB;
constexpr size_t WS_FFT2 = 5 * MiB;
constexpr size_t WS_CHDFT = 5 * MiB + 65536;
constexpr size_t WS_WRT = 6 * MiB;
constexpr size_t WS_ROUTE = 8 * MiB;
constexpr size_t WS_WIN = 12 * MiB;
constexpr size_t WS_WOUT = 23 * MiB;
constexpr size_t WS_WFO = 27 * MiB;
constexpr size_t WS_WPP = 31 * MiB;
constexpr size_t WS_WGU = 39 * MiB;
constexpr size_t WS_WD = 295 * MiB;
constexpr size_t WS_XB = 423 * MiB;
constexpr size_t WS_X1B = 487 * MiB;
constexpr size_t WS_SCR = 551 * MiB;
constexpr size_t WS_END = 951 * MiB;
constexpr size_t SC_H = 0;
constexpr size_t SC_KV = 176 * MiB;
constexpr size_t SC_RT = 304 * MiB;
constexpr size_t SC_YCAT = 176 * MiB;
constexpr size_t SC_YPRE = 0;
constexpr size_t SC_A1 = 0;
constexpr size_t SC_V2 = 128 * MiB;
constexpr size_t SC_XS = 0;
constexpr size_t SC_HID = 144 * MiB;
constexpr size_t SC_YS = 216 * MiB;
constexpr size_t RT_TOKE = 0;
constexpr size_t RT_TOKG = 256 * 1024;
constexpr size_t RT_TOKR = 512 * 1024;
constexpr size_t RT_TOKP = 768 * 1024;
constexpr size_t RT_BCNT = 1024 * 1024;
constexpr size_t RT_SGATE = 1024 * 1024 + 65536;
constexpr size_t RT_TILEE = 2048 * 1024;
constexpr int CW_BAR = 4096;

constexpr int LDS_BYTES = 155648;
constexpr int MISC_OFF = 151552;

__device__ __forceinline__ unsigned f2bf(float f) { unsigned u = __builtin_bit_cast(unsigned, f); return (u + 0x7fffu + ((u >> 16) & 1u)) >> 16; }
__device__ __forceinline__ unsigned pk2(float lo, float hi) { return f2bf(lo) | (f2bf(hi) << 16); }
__device__ __forceinline__ float bf_lo(unsigned u) { return __builtin_bit_cast(float, u << 16); }
__device__ __forceinline__ float bf_hi(unsigned u) { return __builtin_bit_cast(float, u & 0xffff0000u); }
__device__ __forceinline__ float bf2f(bf16_t h) { return __builtin_bit_cast(float, (unsigned)h << 16); }
__device__ __forceinline__ float wave_sum(float v) {
#pragma unroll
    for (int o = 1; o < 64; o <<= 1) v += __shfl_xor(v, o);
    return v;
}
__device__ __forceinline__ float silu_f(float g) { return g / (1.0f + __expf(-g)); }

__device__ __forceinline__ void sincos_turn(double frac, double& s, double& c) {
    const double r = frac * 6.283185307179586 * 0.125;
    const double r2 = r * r;
    double sp = 1.0 / 6227020800.0;
    sp = sp * r2 * -1.0 + 1.0 / 39916800.0; sp = sp * r2 * -1.0 + 1.0 / 362880.0; sp = sp * r2 * -1.0 + 1.0 / 5040.0; sp = sp * r2 * -1.0 + 1.0 / 120.0; sp = sp * r2 * -1.0 + 1.0 / 6.0; sp = sp * r2 * -1.0 + 1.0;
    double ss = sp * r;
    double cp = 1.0 / 479001600.0;
    cp = cp * r2 * -1.0 + 1.0 / 3628800.0; cp = cp * r2 * -1.0 + 1.0 / 40320.0; cp = cp * r2 * -1.0 + 1.0 / 720.0; cp = cp * r2 * -1.0 + 1.0 / 24.0; cp = cp * r2 * -1.0 + 0.5; cp = cp * r2 * -1.0 + 1.0;
    double cc = cp;
#pragma unroll
    for (int i = 0; i < 3; ++i) { const double s2 = 2.0 * ss * cc, c2 = cc * cc - ss * ss; ss = s2; cc = c2; }
    s = ss; c = cc;
}
__device__ __forceinline__ void sincos_frac(int p, int N, double& s, double& c) {
    p %= N; if (p < 0) p += N; if (2 * p >= N) p -= N;
    sincos_turn((double)p / (double)N, s, c);
}

#define XB_TMO      128
#define XB_XCNT(j)  (256  + 64 * (j))
#define XB_XSUB(j)  (1280 + 64 * (j))
#define XB_XGEN(j)  (2304 + 64 * (j))
#define XB_TOP      3328
#define XB_TOPGEN   3392
#define XCD_BAR_WORDS 3456
#define XB_SPIN_CAP (1u << 20)
__device__ __forceinline__ unsigned xb_ld(unsigned* p)              { return __hip_atomic_load(p, __ATOMIC_RELAXED, __HIP_MEMORY_SCOPE_AGENT); }
__device__ __forceinline__ unsigned xb_add(unsigned* p, unsigned v) { return __hip_atomic_fetch_add(p, v, __ATOMIC_RELAXED, __HIP_MEMORY_SCOPE_AGENT); }
__device__ __forceinline__ unsigned xb_xcc_id() { return (unsigned)__builtin_amdgcn_s_getreg((3 << 11) | 20) & 0xFu; }
#define XB_SPIN(cond, bar) do { unsigned _sp = 0; while (cond) { __builtin_amdgcn_s_sleep(1); \
    if ((++_sp & 255u) == 0u) { if (xb_ld(&(bar)[XB_TMO])) break; if (_sp > XB_SPIN_CAP) { atomicAdd(&(bar)[XB_TMO], 1u); break; } } } } while (0)
struct XcdBarrier { unsigned* bar; unsigned x; volatile LAS unsigned* st; };
__device__ __forceinline__ XcdBarrier xcd_barrier_post(unsigned* bar, volatile LAS unsigned* st) {
    XcdBarrier b; b.bar = bar; b.x = xb_xcc_id(); b.st = st;
    if (threadIdx.x == 0) (void)xb_add(&bar[XB_XCNT(b.x)], 1u);
    return b;
}
__device__ __forceinline__ void xcd_barrier_complete(unsigned* bar, unsigned x, unsigned& nloc, unsigned& nx) {
    const unsigned G = gridDim.x * gridDim.y * gridDim.z;
    unsigned sum, cnt, mine, sp = 0u;
    for (;;) {
        sum = 0u; cnt = 0u; mine = 0u;
#pragma unroll
        for (unsigned j = 0; j < 16; ++j) { const unsigned c = xb_ld(&bar[XB_XCNT(j)]); sum += c; cnt += (c > 0u) ? 1u : 0u; mine = (j == x) ? c : mine; }
        if (sum == G) break;
        __builtin_amdgcn_s_sleep(1);
        if ((++sp & 255u) == 0u) { if (xb_ld(&bar[XB_TMO])) break; if (sp > XB_SPIN_CAP) { atomicAdd(&bar[XB_TMO], 1u); break; } }
    }
    nloc = mine > 0u ? mine : 1u; nx = cnt > 0u ? cnt : 1u;
}
__device__ __forceinline__ void xcd_barrier(const XcdBarrier& b) {
    asm volatile("s_waitcnt vmcnt(0)" ::: "memory");
    __syncthreads();
    if (threadIdx.x == 0) {
        unsigned* bar = b.bar;
        __builtin_amdgcn_s_waitcnt(0);
        unsigned nloc = b.st[0], nx = b.st[1];
        if (nloc == 0u) { xcd_barrier_complete(bar, b.x, nloc, nx); b.st[0] = nloc; b.st[1] = nx; }
        const unsigned old = xb_add(&bar[XB_XSUB(b.x)], 1u);
        const unsigned gen = old / nloc;
        if (old + 1u == (gen + 1u) * nloc) {
            __builtin_amdgcn_fence(__ATOMIC_RELEASE, "agent");
            asm volatile("s_waitcnt vmcnt(0)" ::: "memory");
            const unsigned og = xb_add(&bar[XB_TOP], 1u);
            const unsigned tg = og / nx;
            if (og + 1u == (tg + 1u) * nx) xb_add(&bar[XB_TOPGEN], 1u);
            else XB_SPIN(xb_ld(&bar[XB_TOPGEN]) == tg, bar);
            __builtin_amdgcn_fence(__ATOMIC_ACQUIRE, "agent");
            xb_add(&bar[XB_XGEN(b.x)], 1u);
            asm volatile("s_waitcnt vmcnt(0)" ::: "memory");
        } else {
            XB_SPIN(xb_ld(&bar[XB_XGEN(b.x)]) == gen, bar);
            __builtin_amdgcn_fence(__ATOMIC_ACQUIRE, "agent");
            asm volatile("s_waitcnt vmcnt(0)" ::: "memory");
        }
    }
    __syncthreads();
}

namespace pg8 {
constexpr int BM = 256, BK = 64, HALF = 128, HTB = HALF * BK * 2, STAGE_BYTES = 8 * HTB, NXCD = 8, WGM = 8;
__host__ __device__ __forceinline__ int lds_byte(int r, int c) { const int st = (r >> 4) * 2 + (c >> 5), rr = r & 15, cc = c & 31, ob = rr * 64 + cc * 2; return st * 1024 + (ob ^ (((ob >> 9) & 1) << 5)); }
__host__ __device__ __forceinline__ void stage_rc(int b, int& R, int& C) { const int st = b / 1024, sb = b % 1024, swz = sb ^ (((sb >> 9) & 1) << 5); R = (st >> 1) * 16 + swz / 64; C = (st & 1) * 32 + (swz % 64) / 2; }
__host__ __device__ __forceinline__ int perm32(int rho) { const int n = rho >> 4, i = rho & 15; return 8 * (i >> 2) + 4 * n + (i & 3); }

struct Unit { int pm, pn, tag, pad; const char* a; const char* b; };

__device__ __forceinline__ bool static_order(int i, int G, int c, int nM, int nN, int& pm, int& pn) {
    const int nwg = nM * nN; const long L = (long)i * G + c; if (L >= nwg) return false;
    int wgid = (int)L; { const int q = nwg / NXCD, r = nwg % NXCD, xcd = wgid % NXCD, off = wgid / NXCD; wgid = (xcd < r ? xcd * (q + 1) : r * (q + 1) + (xcd - r) * q) + off; }
    const int nig = WGM * nN, gid = wgid / nig, fm = gid * WGM, gsz = (nM - fm) < WGM ? (nM - fm) : WGM;
    pm = fm + ((wgid % nig) % gsz); pn = (wgid % nig) / gsz; return true;
}
struct DenseOrder {
    const char* A; const char* Bt; int lda, ldb, nM, nN, G, c;
    __device__ __forceinline__ bool next(int i, Unit& u) const {
        if (!static_order(i, G, c, nM, nN, u.pm, u.pn)) return false;
        u.tag = 0; u.pad = 0; u.a = A + (size_t)u.pm * BM * lda * 2; u.b = Bt + (size_t)u.pn * BM * ldb * 2; return true;
    }
};
struct GroupedOrder {
    const char* A; const char* W; const int* tile_e; size_t estride; int lda, ldb, nM, nN, G, c;
    __device__ __forceinline__ bool next(int i, Unit& u) const {
        if (!static_order(i, G, c, nM, nN, u.pm, u.pn)) return false;
        const int e = __builtin_amdgcn_readfirstlane(tile_e[u.pm]);
        u.tag = e; u.pad = 0; u.a = A + (size_t)u.pm * BM * lda * 2; u.b = W + (size_t)e * estride + (size_t)u.pn * BM * ldb * 2; return true;
    }
};

__device__ __forceinline__ unsigned cvt_pk_bf16(float lo, float hi) { unsigned r; asm volatile("v_cvt_pk_bf16_f32 %0, %1, %2" : "=v"(r) : "v"(lo), "v"(hi)); return r; }

template <class Epi, class Sched, bool ALIGN_EPI>
__device__ __forceinline__ void gemm_phase(ldsp lds, const int tid, const int lda, const int ldb, const int K, const Sched& S, const Epi& E) {
    const int wid = __builtin_amdgcn_readfirstlane(tid >> 6), lane = tid & 63, wr = wid >> 2, wc = wid & 3, fr = lane & 15, fq = lane >> 4;
    const int nt = K / BK;
    unsigned voffA[2], voffB[2];
#pragma unroll
    for (int i = 0; i < 2; ++i) { int R, C; stage_rc(tid * 16 + i * 8192, R, C); const int Rb = Epi::PERM ? ((R & ~31) + perm32(R & 31)) : R;
        voffA[i] = (unsigned)(R * lda + C) * 2u; voffB[i] = (unsigned)(Rb * ldb + C) * 2u; }
    const size_t kstep = (size_t)(BK * 2);
    const size_t hstepA = (size_t)HALF * lda * 2, hstepB = (size_t)HALF * ldb * 2;
    const unsigned ldsw = (unsigned)wid * 1024u;
    const int aoff = lds_byte(wr * 64 + fr, fq * 8), boff = lds_byte(wc * 32 + fr, fq * 8);
#define PG8_SA(b, h) (((b) * 2 + (h)) * HTB)
#define PG8_SB(b, h) ((4 + (b) * 2 + (h)) * HTB)
#define PG8_STAGE(bufoff, gbase, voff) do { _Pragma("unroll") for (int _i = 0; _i < 2; ++_i) \
        __builtin_amdgcn_global_load_lds((const unsigned*)((const char*)(gbase) + (voff)[_i]), (LAS unsigned*)(lds + (bufoff) + ldsw + _i * 8192), 16, 0, 0); } while (0)
#define PG8_LDA(dst, b, h) do { _Pragma("unroll") for (int m = 0; m < 4; ++m) _Pragma("unroll") for (int k = 0; k < 2; ++k) dst[m][k] = *(const LAS bf16x8*)(lds + PG8_SA(b, h) + aoff + m * 2048 + k * 1024); } while (0)
#define PG8_LDB(dst, b, h) do { _Pragma("unroll") for (int n = 0; n < 2; ++n) _Pragma("unroll") for (int k = 0; k < 2; ++k) dst[n][k] = *(const LAS bf16x8*)(lds + PG8_SB(b, h) + boff + n * 2048 + k * 1024); } while (0)
#define PG8_MMA(ai, bj, At, Bt) do { __builtin_amdgcn_s_setprio(1); _Pragma("unroll") for (int m = 0; m < 4; ++m) _Pragma("unroll") for (int n = 0; n < 2; ++n) _Pragma("unroll") for (int k = 0; k < 2; ++k) \
        acc[ai][bj][m][n] = __builtin_amdgcn_mfma_f32_16x16x32_bf16(Bt[n][k], At[m][k], acc[ai][bj][m][n], 0, 0, 0); __builtin_amdgcn_s_setprio(0); } while (0)
#define PG8_WAIT_V(n) asm volatile("s_waitcnt vmcnt(" #n ")" ::: "memory")
#define PG8_WAIT_L(n) asm volatile("s_waitcnt lgkmcnt(" #n ")" ::: "memory")
#define PG8_BAR __builtin_amdgcn_s_barrier()
#define PG8_SCHED __builtin_amdgcn_sched_barrier(0)
    Unit cur, nxt; int ui = 0;
    if (!S.next(0, cur)) return;
    f32x4 acc[2][2][4][2];
#pragma unroll
    for (int a = 0; a < 2; ++a)
#pragma unroll
        for (int b = 0; b < 2; ++b)
#pragma unroll
            for (int m = 0; m < 4; ++m)
#pragma unroll
                for (int n = 0; n < 2; ++n) acc[a][b][m][n] = (f32x4){0.f, 0.f, 0.f, 0.f};
    bf16x8 At[4][2], B0[2][2], B1[2][2];
    const char* cA = cur.a; const char* cB = cur.b;
    PG8_STAGE(PG8_SB(0, 0), cB, voffB); PG8_STAGE(PG8_SB(0, 1), cB + hstepB, voffB); PG8_STAGE(PG8_SA(0, 0), cA, voffA); PG8_STAGE(PG8_SA(0, 1), cA + hstepA, voffA);
    if (wr == 1) PG8_BAR;
    PG8_WAIT_V(2); PG8_BAR;
    PG8_STAGE(PG8_SB(1, 0), cB + kstep, voffB); PG8_STAGE(PG8_SA(1, 0), cA + kstep, voffA); PG8_STAGE(PG8_SB(1, 1), cB + hstepB + kstep, voffB);
    PG8_WAIT_V(6); PG8_BAR;
    for (;;) {
        const bool has_next = S.next(ui + 1, nxt);
        const char* nA = has_next ? nxt.a : cA; const char* nB = has_next ? nxt.b : cB;
#pragma unroll 1
        for (int t = 0; t < nt; t += 2) {
            const bool last = (t == nt - 2);
            const char* a1 = cA + (size_t)(t + 1) * kstep;
            const char* a2 = last ? nA : cA + (size_t)(t + 2) * kstep; const char* b2 = last ? nB : cB + (size_t)(t + 2) * kstep;
            const char* a3 = a2 + kstep; const char* b3 = b2 + kstep;
            PG8_LDB(B0, 0, 0); PG8_LDB(B1, 0, 1); PG8_SCHED; PG8_LDA(At, 0, 0); PG8_STAGE(PG8_SA(1, 1), a1 + hstepA, voffA);
            PG8_WAIT_V(8); PG8_WAIT_L(0); PG8_BAR; PG8_MMA(0, 0, At, B0); PG8_MMA(0, 1, At, B1); PG8_BAR; PG8_SCHED;
            PG8_LDA(At, 0, 1); PG8_STAGE(PG8_SB(0, 0), b2, voffB); PG8_STAGE(PG8_SB(0, 1), b2 + hstepB, voffB); PG8_STAGE(PG8_SA(0, 0), a2, voffA);
            PG8_WAIT_V(8); PG8_WAIT_L(0); PG8_BAR; PG8_MMA(1, 0, At, B0); PG8_MMA(1, 1, At, B1); PG8_BAR; PG8_SCHED;
            PG8_LDB(B0, 1, 0); PG8_LDB(B1, 1, 1); PG8_SCHED; PG8_LDA(At, 1, 0); PG8_STAGE(PG8_SA(0, 1), a2 + hstepA, voffA);
            PG8_WAIT_V(8); PG8_WAIT_L(0); PG8_BAR; PG8_MMA(0, 0, At, B0); PG8_MMA(0, 1, At, B1); PG8_BAR; PG8_SCHED;
            PG8_LDA(At, 1, 1); PG8_STAGE(PG8_SB(1, 0), b3, voffB); PG8_STAGE(PG8_SB(1, 1), b3 + hstepB, voffB); PG8_STAGE(PG8_SA(1, 0), a3, voffA);
            PG8_WAIT_V(8); PG8_WAIT_L(0); PG8_BAR; PG8_MMA(1, 0, At, B0); PG8_MMA(1, 1, At, B1); PG8_BAR; PG8_SCHED;
        }
        if constexpr (ALIGN_EPI) { if (wr == 0) PG8_BAR; }
        E(acc, cur, wr, wc, fr, fq);
        if (!has_next) break;
#pragma unroll
        for (int a = 0; a < 2; ++a)
#pragma unroll
            for (int b = 0; b < 2; ++b)
#pragma unroll
                for (int m = 0; m < 4; ++m)
#pragma unroll
                    for (int n = 0; n < 2; ++n) acc[a][b][m][n] = (f32x4){0.f, 0.f, 0.f, 0.f};
        cur = nxt; cA = nA; cB = nB; ++ui;
        if constexpr (ALIGN_EPI) { if (wr == 1) PG8_BAR; }
    }
    PG8_WAIT_V(0);
    if constexpr (!ALIGN_EPI) { if (wr == 0) PG8_BAR; }
    PG8_BAR;
#undef PG8_SA
#undef PG8_SB
#undef PG8_STAGE
#undef PG8_LDA
#undef PG8_LDB
#undef PG8_MMA
#undef PG8_WAIT_V
#undef PG8_WAIT_L
#undef PG8_BAR
#undef PG8_SCHED
}

typedef const f32x4 (&AccRef)[2][2][4][2];

struct EpiInProj {
    static constexpr bool PERM = true;
    bf16_t* H; const f32x2* rope64; const f32x2* rope32;
    __device__ __forceinline__ void operator()(AccRef acc, const Unit& u, int wr, int wc, int fr, int fq) const {
        const int pn = u.pn;
#pragma unroll
        for (int bj = 0; bj < 2; ++bj) {
            const int c0 = pn * BM + bj * HALF + wc * 32 + 8 * fq;
            int mode; float sc = 1.0f;
            if (pn < 4) { mode = 1; if (pn >= 2) sc = 0.08838834764831845f; }
            else if (pn == 8 || pn == 9) { mode = 2; sc = 0.125f; }
            else if (pn == 10 && bj == 0) { mode = 2; }
            else mode = 0;
#pragma unroll
            for (int ai = 0; ai < 2; ++ai)
#pragma unroll
                for (int m = 0; m < 4; ++m) {
                    const int row = u.pm * BM + ai * HALF + wr * 64 + m * 16 + fr;
                    f32x4 v0 = acc[ai][bj][m][0], v1 = acc[ai][bj][m][1];
                    if (mode != 0) {
                        const int s = row & (SEQ - 1);
                        const f32x4* tp = (mode == 1) ? (const f32x4*)(rope64 + (size_t)s * 64 + ((c0 & 127) >> 1)) : (const f32x4*)(rope32 + (size_t)s * 32 + ((c0 & 63) >> 1));
                        const f32x4 t0 = tp[0], t1 = tp[1];
                        f32x4 o0, o1;
                        o0[0] = v0[0] * t0[0] - v0[1] * t0[1]; o0[1] = v0[0] * t0[1] + v0[1] * t0[0];
                        o0[2] = v0[2] * t0[2] - v0[3] * t0[3]; o0[3] = v0[2] * t0[3] + v0[3] * t0[2];
                        o1[0] = v1[0] * t1[0] - v1[1] * t1[1]; o1[1] = v1[0] * t1[1] + v1[1] * t1[0];
                        o1[2] = v1[2] * t1[2] - v1[3] * t1[3]; o1[3] = v1[2] * t1[3] + v1[3] * t1[2];
                        v0 = o0 * sc; v1 = o1 * sc;
                    }
                    u32x4 w; w.x = cvt_pk_bf16(v0[0], v0[1]); w.y = cvt_pk_bf16(v0[2], v0[3]); w.z = cvt_pk_bf16(v1[0], v1[1]); w.w = cvt_pk_bf16(v1[2], v1[3]);
                    *(u32x4*)(H + (size_t)row * IN_EVEN + c0) = w;
                }
        }
    }
};
struct EpiResid {
    static constexpr bool PERM = false;
    const bf16_t* XB; float* Y;
    __device__ __forceinline__ void operator()(AccRef acc, const Unit& u, int wr, int wc, int fr, int fq) const {
#pragma unroll
        for (int ai = 0; ai < 2; ++ai)
#pragma unroll
            for (int m = 0; m < 4; ++m) {
                const size_t row = (size_t)(u.pm * BM + ai * HALF + wr * 64 + m * 16 + fr);
#pragma unroll
                for (int bj = 0; bj < 2; ++bj)
#pragma unroll
                    for (int n = 0; n < 2; ++n) {
                        const int c = u.pn * BM + bj * HALF + wc * 32 + n * 16 + 4 * fq;
                        const u32x2 xb = *(const u32x2*)(XB + row * DM + c);
                        f32x4 o = acc[ai][bj][m][n];
                        o[0] += ALPHA * bf_lo(xb.x); o[1] += ALPHA * bf_hi(xb.x); o[2] += ALPHA * bf_lo(xb.y); o[3] += ALPHA * bf_hi(xb.y);
                        *(f32x4*)(Y + row * DM + c) = o;
                    }
            }
    }
};
struct EpiGateUp {
    static constexpr bool PERM = true;
    bf16_t* HID;
    __device__ __forceinline__ void operator()(AccRef acc, const Unit& u, int wr, int wc, int fr, int fq) const {
#pragma unroll
        for (int ai = 0; ai < 2; ++ai)
#pragma unroll
            for (int m = 0; m < 4; ++m) {
                const size_t row = (size_t)(u.pm * BM + ai * HALF + wr * 64 + m * 16 + fr);
#pragma unroll
                for (int bj = 0; bj < 2; ++bj) {
                    const int c0 = u.pn * BM + bj * HALF + wc * 32 + 8 * fq;
                    const f32x4 v0 = acc[ai][bj][m][0], v1 = acc[ai][bj][m][1];
                    u32x2 w; w.x = cvt_pk_bf16(silu_f(v0[0]) * v0[1], silu_f(v0[2]) * v0[3]); w.y = cvt_pk_bf16(silu_f(v1[0]) * v1[1], silu_f(v1[2]) * v1[3]);
                    *(u32x2*)(HID + row * EH + (c0 >> 1)) = w;
                }
            }
    }
};
struct EpiDown {
    static constexpr bool PERM = true;
    bf16_t* YS; const float* gate;
    __device__ __forceinline__ void operator()(AccRef acc, const Unit& u, int wr, int wc, int fr, int fq) const {
#pragma unroll
        for (int ai = 0; ai < 2; ++ai)
#pragma unroll
            for (int m = 0; m < 4; ++m) {
                const size_t row = (size_t)(u.pm * BM + ai * HALF + wr * 64 + m * 16 + fr);
                const float g = gate[row];
#pragma unroll
                for (int bj = 0; bj < 2; ++bj) {
                    const int c0 = u.pn * BM + bj * HALF + wc * 32 + 8 * fq;
                    const f32x4 v0 = acc[ai][bj][m][0] * g, v1 = acc[ai][bj][m][1] * g;
                    u32x4 w; w.x = cvt_pk_bf16(v0[0], v0[1]); w.y = cvt_pk_bf16(v0[2], v0[3]); w.z = cvt_pk_bf16(v1[0], v1[1]); w.w = cvt_pk_bf16(v1[2], v1[3]);
                    *(u32x4*)(YS + row * DM + c0) = w;
                }
            }
    }
};
struct EpiWpp {
    static constexpr bool PERM = true;
    bf16_t* WPP;
    __device__ __forceinline__ void operator()(AccRef acc, const Unit& u, int wr, int wc, int fr, int fq) const {
        const int o = u.tag >> 2, g = u.tag & 3;
        bf16_t* base = WPP + (size_t)o * 1024 * 2048 + u.pn * 1024 + g * 256;
#pragma unroll
        for (int ai = 0; ai < 2; ++ai)
#pragma unroll
            for (int m = 0; m < 4; ++m) {
                const size_t row = (size_t)(u.pm * BM + ai * HALF + wr * 64 + m * 16 + fr);
#pragma unroll
                for (int bj = 0; bj < 2; ++bj) {
                    const int c0 = bj * HALF + wc * 32 + 8 * fq;
                    const f32x4 v0 = acc[ai][bj][m][0], v1 = acc[ai][bj][m][1];
                    u32x4 w; w.x = cvt_pk_bf16(v0[0], v0[1]); w.y = cvt_pk_bf16(v0[2], v0[3]); w.z = cvt_pk_bf16(v1[0], v1[1]); w.w = cvt_pk_bf16(v1[2], v1[3]);
                    *(u32x4*)(base + row * 2048 + c0) = w;
                }
            }
    }
};
struct WppOrder {
    const char* WFO; const char* CH; int G, c;
    __device__ __forceinline__ bool next(int i, Unit& u) const {
        const int L = i * G + c; if (L >= 64) return false;
        const int o = L >> 5, g = (L >> 3) & 3, pm = (L >> 1) & 3, pn = L & 1;
        u.pm = pm; u.pn = pn; u.tag = (o << 2) | g; u.pad = 0;
        u.a = WFO + (size_t)o * 1024 * 1024 * 2 + (size_t)pm * BM * 1024 * 2 + (size_t)g * 256 * 2;
        u.b = CH + (size_t)pn * BM * 256 * 2; return true;
    }
};
}

__device__ __forceinline__ bf16x8 frag_row(ldsp base, int rs, int r0, int k0, int lane) {
    return *(const LAS bf16x8*)(base + (r0 + (lane & 15)) * rs + (k0 + 8 * (lane >> 4)) * 2);
}
__device__ __forceinline__ unsigned tr_lane_base(unsigned base_u32, int rs, int lane) {
    const int g = lane >> 4, q = (lane & 15) >> 2, p = lane & 3;
    return base_u32 + (unsigned)((8 * g + q) * rs + 8 * p);
}
__device__ __forceinline__ bf16x8 frag_tr(unsigned lane_base, const int rs, const int k0, const int n0, int  ) {
    bf16x4 r0, r1;
    asm volatile("ds_read_b64_tr_b16 %0, %2 offset:%3\n\tds_read_b64_tr_b16 %1, %2 offset:%4\n\ts_waitcnt lgkmcnt(0)" : "=&v"(r0), "=&v"(r1) : "v"(lane_base), "i"(k0 * rs + n0 * 2), "i"(k0 * rs + n0 * 2 + 4 * rs) : "memory");
    bf16x8 r; r[0] = r0[0]; r[1] = r0[1]; r[2] = r0[2]; r[3] = r0[3]; r[4] = r1[0]; r[5] = r1[1]; r[6] = r1[2]; r[7] = r1[3];
    return r;
}
#define MFMA16(a, b, c) __builtin_amdgcn_mfma_f32_16x16x32_bf16((a), (b), (c), 0, 0, 0)

template <int ROWS, int CPR>
__device__ __forceinline__ void stage_tile(ldsp dst, int rs, const unsigned char* src, size_t gs, int tid) {
#pragma unroll
    for (int c = tid; c < ROWS * CPR; c += 512) { const int r = c / CPR, ch = c % CPR; const u32x4 v = *(const u32x4*)(src + (size_t)r * gs + ch * 16); *(LAS u32x4*)(dst + r * rs + ch * 16) = v; }
}

struct Args { const float* in[18]; float* out; unsigned char* ws; int ph_lo, ph_hi; };
enum { I_X = 0, I_WIN, I_DECAY, I_GN, I_SINK, I_WOUT, I_WFO, I_LN1G, I_LN1B, I_LN2G, I_LN2B, I_RCW, I_RCB, I_RFW, I_RFB, I_EWG, I_EWU, I_EWD };

struct Frame { ldsp lds; unsigned lds_u32; int tid, lane, wave, vcu, G; unsigned char* ws; };

template <int MAP>
__device__ __forceinline__ void p0_transpose_item(const float* W, int K, int N, bf16_t* WT, LAS float* scr, int item, int lane) {
    const int nblk = N / 32, kb = item / nblk, nb = item % nblk, k0 = 64 * kb, n0 = 32 * nb;
#pragma unroll 8
    for (int i = 0; i < 32; ++i) { const int kk = 2 * i + (lane >> 5); scr[kk * 33 + (lane & 31)] = W[(size_t)(k0 + kk) * N + n0 + (lane & 31)]; }
    asm volatile("s_waitcnt lgkmcnt(0)" ::: "memory");
    const int c = lane & 7;
#pragma unroll
    for (int j = 0; j < 4; ++j) { const int n = (lane >> 3) + 8 * j; const LAS float* s = scr + (8 * c) * 33 + n;
        u32x4 o; o.x = pk2(s[0 * 33], s[1 * 33]); o.y = pk2(s[2 * 33], s[3 * 33]); o.z = pk2(s[4 * 33], s[5 * 33]); o.w = pk2(s[6 * 33], s[7 * 33]);
        int nn = n0 + n;
        if (MAP == 1) {
            if (nn < 1024) { const int hd = nn >> 7, jj = nn & 127; nn = hd * 128 + 2 * (jj & 63) + (jj >> 6); }
            else if (nn >= C_QB && nn < C_VB) { const int mm = nn - C_QB, hd = mm >> 6, jj = mm & 63; nn = C_QB + hd * 64 + 2 * (jj & 31) + (jj >> 5); }
        } else if (MAP == 2) nn = 2 * nn; else if (MAP == 3) nn = 2 * nn + 1;
        *(u32x4*)(WT + (size_t)nn * K + k0 + 8 * c) = o; }
    asm volatile("s_waitcnt lgkmcnt(0)" ::: "memory");
}
__device__ __forceinline__ void p0a_prologue(const Frame& F, const Args& a) {
    LAS float* scr = (LAS float*)(F.lds + F.wave * 16384);
    const int gw = F.vcu * 8 + F.wave, NGW = F.G * 8;
    unsigned char* ws = F.ws;
    constexpr int I_IN = 16 * 88, I_SQ = 16 * 32, I_GU = 16 * 16, I_DN = 8 * 32;
    constexpr int N0 = 2 * I_IN, N1 = N0 + 2 * I_SQ, N2 = N1 + 2 * I_SQ, N3 = N2 + 128 * I_GU, N4 = N3 + 128 * I_GU, N5 = N4 + 128 * I_DN;
    for (int it = gw; it < N5; it += NGW) {
        if (it < N0) { const int e = it / I_IN, r = it % I_IN; p0_transpose_item<1>(a.in[I_WIN] + (size_t)e * 1024 * IN_EVEN, 1024, IN_EVEN, (bf16_t*)(ws + WS_WIN) + (size_t)e * IN_EVEN * 1024, scr, r, F.lane); }
        else if (it < N1) { const int q = it - N0, e = q / I_SQ, r = q % I_SQ; p0_transpose_item<0>(a.in[I_WOUT] + (size_t)e * 1024 * 1024, 1024, 1024, (bf16_t*)(ws + WS_WOUT) + (size_t)e * 1024 * 1024, scr, r, F.lane); }
        else if (it < N2) { const int q = it - N1, e = q / I_SQ, r = q % I_SQ; p0_transpose_item<0>(a.in[I_WFO] + (size_t)e * 1024 * 1024, 1024, 1024, (bf16_t*)(ws + WS_WFO) + (size_t)e * 1024 * 1024, scr, r, F.lane); }
        else if (it < N3) { const int q = it - N2, e = q / I_GU, r = q % I_GU; p0_transpose_item<2>(a.in[I_EWG] + (size_t)e * 1024 * EH, 1024, EH, (bf16_t*)(ws + WS_WGU) + (size_t)e * 1024 * 1024, scr, r, F.lane); }
        else if (it < N4) { const int q = it - N3, e = q / I_GU, r = q % I_GU; p0_transpose_item<3>(a.in[I_EWU] + (size_t)e * 1024 * EH, 1024, EH, (bf16_t*)(ws + WS_WGU) + (size_t)e * 1024 * 1024, scr, r, F.lane); }
        else { const int q = it - N4, e = q / I_DN, r = q % I_DN; p0_transpose_item<0>(a.in[I_EWD] + (size_t)e * EH * 1024, EH, 1024, (bf16_t*)(ws + WS_WD) + (size_t)e * 1024 * EH, scr, r, F.lane); }
    }
    const int gt = F.vcu * 512 + F.tid, NGT = F.G * 512;
    {
        f32x2* r64 = (f32x2*)(ws + WS_ROPE64); f32x2* r32 = (f32x2*)(ws + WS_ROPE32);
        for (int idx = gt; idx < SEQ * 96; idx += NGT) {
            const int s = idx / 96, i = idx % 96; const bool big = i < 64; const int ii = big ? i : i - 64;
            const double base = big ? 0.8659643233600653 : 0.7498942093324558;
            double inv = 1.0; for (int k = 0; k < ii; ++k) inv *= base;
            const double turns = (double)s * inv * 0.15915494309189535;
            const double fr = turns - __builtin_rint(turns);
            double sn, cs; sincos_turn(fr, sn, cs);
            const f32x2 v = {(float)cs, (float)sn};
            if (big) r64[(size_t)s * 64 + ii] = v; else r32[(size_t)s * 32 + ii] = v;
        }
    }
    {
        bf16_t* t1 = (bf16_t*)(ws + WS_FFT1);
        for (int idx = gt; idx < 64 * 128 * 64; idx += NGT) {
            const int n2 = idx >> 13, row = (idx >> 6) & 127, n1 = idx & 63, k1 = row & 63;
            double sn, cs; sincos_frac(k1 * (64 * n1 + n2), 4096, sn, cs);
            t1[idx] = (bf16_t)f2bf((float)((row < 64 ? cs : -sn) * (1.0 / 64.0)));
        }
        bf16_t* t2 = (bf16_t*)(ws + WS_FFT2);
        for (int idx = gt; idx < 128 * 128; idx += NGT) {
            const int r = idx >> 7, c = idx & 127, k2 = r & 63, n2 = c & 63, ri = r >> 6, rj = c >> 6;
            double sn, cs; sincos_frac(k2 * n2, 64, sn, cs);
            const double v = (ri == rj) ? cs : (ri == 0 ? sn : -sn);
            t2[idx] = (bf16_t)f2bf((float)v);
        }
        bf16_t* t3 = (bf16_t*)(ws + WS_CHDFT);
        for (int idx = gt; idx < 512 * 256; idx += NGT) {
            const int r = idx >> 8, cp = idx & 255, c = r & 255, ri = r >> 8;
            double sn, cs; sincos_frac(c * cp, 256, sn, cs);
            t3[idx] = (bf16_t)f2bf((float)((ri == 0 ? cs : sn) * (1.0 / 16.0)));
        }
        float* wr = (float*)(ws + WS_WRT);
        for (int idx = gt; idx < DEPTH * 36 * 1024; idx += NGT) {
            const int L = idx / (36 * 1024), o = (idx / 1024) % 36, k = idx & 1023;
            wr[idx] = (o < 4) ? a.in[I_RCW][((size_t)L * 1024 + k) * 4 + o] : a.in[I_RFW][((size_t)L * 1024 + k) * 32 + (o - 4)];
        }
    }
    {
        const f32x4* x4 = (const f32x4*)a.in[I_X]; u32x2* xb = (u32x2*)(ws + WS_XB);
        for (size_t idx = gt; idx < (size_t)NT * DM / 4; idx += NGT) { const f32x4 v = x4[idx]; u32x2 o; o.x = pk2(v[0], v[1]); o.y = pk2(v[2], v[3]); xb[idx] = o; }
    }
}

__device__ __forceinline__ float log2_sigmoid(float z) { return -__log2f(1.0f + __expf(-z)); }
constexpr int RS128 = 272;
__device__ __forceinline__ void a2_ret_states(const Frame& F, const float* decay  ) {
    const bf16_t* H = (const bf16_t*)(F.ws + WS_SCR + SC_H);
    float* KV = (float*)(F.ws + WS_SCR + SC_KV);
    const ldsp Vt = F.lds, Kf = F.lds + 128 * RS128, Kb = F.lds + 2 * 128 * RS128;
    const unsigned uV = tr_lane_base(F.lds_u32, RS128, F.lane), uKf = uV + 128 * RS128, uKb = uV + 2 * 128 * RS128;
    const int lane = F.lane, w = F.wave;
    for (int u = F.vcu; u < 1024; u += F.G) {
        const int b = u >> 7, hh = (u >> 5) & 3, n = u & 31;
        const size_t t0 = (size_t)b * SEQ + n * 128;
        const float lgf = log2_sigmoid(decay[hh]), lgb = log2_sigmoid(decay[4 + hh]);
        __syncthreads();
#pragma unroll
        for (int c = F.tid; c < 128 * 16; c += 512) {
            const int r = c >> 4, ch = c & 15;
            const u32x4 vv = *(const u32x4*)(H + (t0 + r) * IN_EVEN + C_VA + hh * 128 + ch * 8);
            *(LAS u32x4*)(Vt + r * RS128 + ch * 16) = vv;
            const u32x4 kk = *(const u32x4*)(H + (t0 + r) * IN_EVEN + C_KA + hh * 128 + ch * 8);
            const float zf = exp2f(lgf * (float)(127 - r)), zb = exp2f(lgb * (float)r);
            u32x4 of, ob;
            of.x = pk2(bf_lo(kk.x) * zf, bf_hi(kk.x) * zf); of.y = pk2(bf_lo(kk.y) * zf, bf_hi(kk.y) * zf); of.z = pk2(bf_lo(kk.z) * zf, bf_hi(kk.z) * zf); of.w = pk2(bf_lo(kk.w) * zf, bf_hi(kk.w) * zf);
            ob.x = pk2(bf_lo(kk.x) * zb, bf_hi(kk.x) * zb); ob.y = pk2(bf_lo(kk.y) * zb, bf_hi(kk.y) * zb); ob.z = pk2(bf_lo(kk.z) * zb, bf_hi(kk.z) * zb); ob.w = pk2(bf_lo(kk.w) * zb, bf_hi(kk.w) * zb);
            *(LAS u32x4*)(Kf + r * RS128 + ch * 16) = of;
            *(LAS u32x4*)(Kb + r * RS128 + ch * 16) = ob;
        }
        __syncthreads();
        f32x4 af[8], ab[8];
#pragma unroll
        for (int i = 0; i < 8; ++i) { af[i] = (f32x4){0.f, 0.f, 0.f, 0.f}; ab[i] = (f32x4){0.f, 0.f, 0.f, 0.f}; }
#pragma unroll
        for (int ks = 0; ks < 4; ++ks) {
            const bf16x8 a = frag_tr(uV + 32 * w, RS128, 32 * ks, 0, lane);
#pragma unroll
            for (int nt = 0; nt < 8; ++nt) {
                const bf16x8 bf = frag_tr(uKf, RS128, 32 * ks, 16 * nt, lane);
                af[nt] = MFMA16(a, bf, af[nt]);
                const bf16x8 bb = frag_tr(uKb, RS128, 32 * ks, 16 * nt, lane);
                ab[nt] = MFMA16(a, bb, ab[nt]);
            }
        }
        float* of = KV + (size_t)u * 2 * 16384; float* ob = of + 16384;
#pragma unroll
        for (int nt = 0; nt < 8; ++nt)
#pragma unroll
            for (int i = 0; i < 4; ++i) {
                const int dv = 16 * w + 4 * (lane >> 4) + i, dk = 16 * nt + (lane & 15);
                of[dv * 128 + dk] = af[nt][i]; ob[dv * 128 + dk] = ab[nt][i];
            }
    }
}
__device__ __forceinline__ void a3_ret_scan(const Frame& F, const float* decay) {
    const float* KV = (const float*)(F.ws + WS_SCR + SC_KV);
    bf16_t* RT = (bf16_t*)(F.ws + WS_SCR + SC_RT);
    for (int it = F.vcu * 512 + F.tid; it < 32 * 2 * 2048; it += F.G * 512) {
        const int bh = it >> 12, dir = (it >> 11) & 1, e8 = (it & 2047) * 8, hh = bh & 3;
        const float cd = exp2f(128.0f * log2_sigmoid(decay[dir * 4 + hh]));
        f32x4 s0 = {0.f, 0.f, 0.f, 0.f}, s1 = {0.f, 0.f, 0.f, 0.f};
        for (int k = 0; k < 32; ++k) {
            const int n = dir ? 31 - k : k;
            const size_t off = ((size_t)(bh * 32 + n) * 2 + dir) * 16384 + e8;
            u32x4 o; o.x = pk2(s0[0], s0[1]); o.y = pk2(s0[2], s0[3]); o.z = pk2(s1[0], s1[1]); o.w = pk2(s1[2], s1[3]);
            *(u32x4*)(RT + off) = o;
            const f32x4 k0 = *(const f32x4*)(KV + off), k1 = *(const f32x4*)(KV + off + 4);
            s0 = s0 * cd + k0; s1 = s1 * cd + k1;
        }
    }
}
__device__ __forceinline__ void a4_ret_unit(const Frame& F, int u, const float* decay, const float* gn_gain) {
    const bf16_t* H = (const bf16_t*)(F.ws + WS_SCR + SC_H);
    const bf16_t* RT = (const bf16_t*)(F.ws + WS_SCR + SC_RT);
    bf16_t* YC = (bf16_t*)(F.ws + WS_SCR + SC_YCAT);
    const ldsp Qs = F.lds, Ks = F.lds + 128 * RS128, Vs = F.lds + 2 * 128 * RS128, Ps = F.lds + 3 * 128 * RS128;
    const unsigned uVs = tr_lane_base(F.lds_u32 + 2 * 128 * RS128, RS128, F.lane);
    const int lane = F.lane, w = F.wave, g = lane >> 4, cl = lane & 15;
    const int b = u >> 7, hh = (u >> 5) & 3, n = u & 31;
    const size_t t0 = (size_t)b * SEQ + n * 128;
    const float lgf = log2_sigmoid(decay[hh]), lgb = log2_sigmoid(decay[4 + hh]);
    __syncthreads();
    stage_tile<128, 16>(Qs, RS128, (const unsigned char*)(H + t0 * IN_EVEN + C_QA + hh * 128), IN_EVEN * 2, F.tid);
    stage_tile<128, 16>(Ks, RS128, (const unsigned char*)(H + t0 * IN_EVEN + C_KA + hh * 128), IN_EVEN * 2, F.tid);
    stage_tile<128, 16>(Vs, RS128, (const unsigned char*)(H + t0 * IN_EVEN + C_VA + hh * 128), IN_EVEN * 2, F.tid);
    __syncthreads();
    f32x4 acc[8];
#pragma unroll
    for (int i = 0; i < 8; ++i) acc[i] = (f32x4){0.f, 0.f, 0.f, 0.f};
#pragma unroll
    for (int ks = 0; ks < 4; ++ks) {
        const bf16x8 a = frag_row(Qs, RS128, 16 * w, 32 * ks, lane);
#pragma unroll
        for (int nt = 0; nt < 8; ++nt) acc[nt] = MFMA16(a, frag_row(Ks, RS128, 16 * nt, 32 * ks, lane), acc[nt]);
    }
#pragma unroll
    for (int nt = 0; nt < 8; ++nt)
#pragma unroll
        for (int i = 0; i < 4; ++i) {
            const int ii = 16 * w + 4 * g + i, jj = 16 * nt + cl, d = ii - jj;
            const float dec = d >= 0 ? exp2f(lgf * (float)d) : exp2f(lgb * (float)(-d));
            *(LAS bf16_t*)(Ps + ii * RS128 + jj * 2) = (bf16_t)f2bf(acc[nt][i] * dec);
        }
    f32x4 y[8];
#pragma unroll
    for (int i = 0; i < 8; ++i) y[i] = (f32x4){0.f, 0.f, 0.f, 0.f};
#pragma unroll
    for (int ks = 0; ks < 4; ++ks) {
        const bf16x8 a = frag_row(Ps, RS128, 16 * w, 32 * ks, lane);
#pragma unroll
        for (int nt = 0; nt < 8; ++nt) y[nt] = MFMA16(a, frag_tr(uVs, RS128, 32 * ks, 16 * nt, lane), y[nt]);
    }
#pragma unroll 1
    for (int dir = 0; dir < 2; ++dir) {
        __syncthreads();
        stage_tile<128, 16>(Ks, RS128, (const unsigned char*)(RT + ((size_t)u * 2 + dir) * 16384), 256, F.tid);
        __syncthreads();
#pragma unroll
        for (int i = 0; i < 8; ++i) acc[i] = (f32x4){0.f, 0.f, 0.f, 0.f};
#pragma unroll
        for (int ks = 0; ks < 4; ++ks) {
            const bf16x8 a = frag_row(Qs, RS128, 16 * w, 32 * ks, lane);
#pragma unroll
            for (int nt = 0; nt < 8; ++nt) acc[nt] = MFMA16(a, frag_row(Ks, RS128, 16 * nt, 32 * ks, lane), acc[nt]);
        }
#pragma unroll
        for (int i = 0; i < 4; ++i) {
            const int il = 16 * w + 4 * g + i;
            const float xi = dir == 0 ? exp2f(lgf * (float)(il + 1)) : exp2f(lgb * (float)(128 - il));
#pragma unroll
            for (int nt = 0; nt < 8; ++nt) y[nt][i] += xi * acc[nt][i];
        }
    }
#pragma unroll
    for (int i = 0; i < 4; ++i) {
        float s = 0.f;
#pragma unroll
        for (int nt = 0; nt < 8; ++nt) s += y[nt][i];
        s += __shfl_xor(s, 1); s += __shfl_xor(s, 2); s += __shfl_xor(s, 4); s += __shfl_xor(s, 8);
        const float mu = s * (1.0f / 128.0f);
        float q = 0.f;
#pragma unroll
        for (int nt = 0; nt < 8; ++nt) { const float d = y[nt][i] - mu; q += d * d; }
        q += __shfl_xor(q, 1); q += __shfl_xor(q, 2); q += __shfl_xor(q, 4); q += __shfl_xor(q, 8);
        const float rstd = 1.0f / sqrtf(q * (1.0f / 128.0f) + GN_EPS);
        const size_t t = t0 + 16 * w + 4 * g + i;
#pragma unroll
        for (int nt = 0; nt < 8; ++nt) {
            const int dv = 16 * nt + cl;
            const float ga = bf2f(H[t * IN_EVEN + C_GA + hh * 128 + dv]);
            const float o = (y[nt][i] - mu) * rstd * gn_gain[hh * 128 + dv] * silu_f(ga);
            YC[t * DM + hh * 128 + dv] = (bf16_t)f2bf(o);
        }
    }
}
constexpr int RS64 = 144;
__device__ __forceinline__ void a4_win_unit(const Frame& F, int u, const float* sink) {
    const bf16_t* H = (const bf16_t*)(F.ws + WS_SCR + SC_H);
    bf16_t* YC = (bf16_t*)(F.ws + WS_SCR + SC_YCAT);
    const ldsp Ks = F.lds, Vs = F.lds + 384 * RS64, Pw = F.lds + 2 * 384 * RS64 + F.wave * (16 * RS128);
    const unsigned uVs = tr_lane_base(F.lds_u32 + 384 * RS64, RS64, F.lane);
    const int lane = F.lane, w = F.wave, g = lane >> 4, cl = lane & 15;
    const int b = u >> 6, kvh = (u >> 5) & 1, n = u & 31;
    const size_t tb = (size_t)b * SEQ;
    __syncthreads();
#pragma unroll
    for (int c = F.tid; c < 384 * 8; c += 512) {
        const int r = c >> 3, ch = c & 7, kp = n * 128 - 128 + r;
        u32x4 kk = {0u, 0u, 0u, 0u}, vv = {0u, 0u, 0u, 0u};
        if (kp >= 0 && kp < SEQ) {
            kk = *(const u32x4*)(H + (tb + kp) * IN_EVEN + C_KB + kvh * 64 + ch * 8);
            vv = *(const u32x4*)(H + (tb + kp) * IN_EVEN + C_VB + kvh * 64 + ch * 8);
        }
        *(LAS u32x4*)(Ks + r * RS64 + ch * 16) = kk;
        *(LAS u32x4*)(Vs + r * RS64 + ch * 16) = vv;
    }
    __syncthreads();
#pragma unroll 1
    for (int gq = 0; gq < 4; ++gq) {
        const int qh = kvh * 4 + gq;
        const float sk = sink[qh];
        const size_t tq = tb + n * 128 + 16 * w;
        bf16x8 qa[2];
#pragma unroll
        for (int ks = 0; ks < 2; ++ks) qa[ks] = *(const bf16x8*)(H + (tq + cl) * IN_EVEN + C_QB + qh * 64 + 32 * ks + 8 * g);
        const int dl0 = cl - (16 * w + 4 * g), kp0 = n * 128 - 128 + cl;
        float mx[4] = {sk, sk, sk, sk};
#pragma unroll 1
        for (int kb = 0; kb < 3; ++kb) {
            f32x4 s[8];
#pragma unroll
            for (int i = 0; i < 8; ++i) s[i] = (f32x4){0.f, 0.f, 0.f, 0.f};
            const ldsp Kb_ = Ks + kb * 128 * RS64;
#pragma unroll
            for (int ks = 0; ks < 2; ++ks)
#pragma unroll
                for (int nt = 0; nt < 8; ++nt) s[nt] = MFMA16(qa[ks], frag_row(Kb_, RS64, 16 * nt, 32 * ks, lane), s[nt]);
#pragma unroll
            for (int nt = 0; nt < 8; ++nt) {
                const int jb = kb * 128 + 16 * nt; const bool okk = (unsigned)(jb + kp0) < (unsigned)SEQ;
#pragma unroll
                for (int i = 0; i < 4; ++i) { const bool ok = okk && ((unsigned)(jb + dl0 - i) <= 256u); mx[i] = fmaxf(mx[i], ok ? s[nt][i] : -1e30f); }
            }
        }
#pragma unroll
        for (int i = 0; i < 4; ++i) { float m = mx[i]; m = fmaxf(m, __shfl_xor(m, 1)); m = fmaxf(m, __shfl_xor(m, 2)); m = fmaxf(m, __shfl_xor(m, 4)); m = fmaxf(m, __shfl_xor(m, 8)); mx[i] = m; }
        float sum[4] = {0.f, 0.f, 0.f, 0.f};
        f32x4 o[4];
#pragma unroll
        for (int i = 0; i < 4; ++i) o[i] = (f32x4){0.f, 0.f, 0.f, 0.f};
#pragma unroll 1
        for (int kb = 0; kb < 3; ++kb) {
            f32x4 s[8];
#pragma unroll
            for (int i = 0; i < 8; ++i) s[i] = (f32x4){0.f, 0.f, 0.f, 0.f};
            const ldsp Kb_ = Ks + kb * 128 * RS64;
#pragma unroll
            for (int ks = 0; ks < 2; ++ks)
#pragma unroll
                for (int nt = 0; nt < 8; ++nt) s[nt] = MFMA16(qa[ks], frag_row(Kb_, RS64, 16 * nt, 32 * ks, lane), s[nt]);
#pragma unroll
            for (int nt = 0; nt < 8; ++nt) {
                const int jb = kb * 128 + 16 * nt; const bool okk = (unsigned)(jb + kp0) < (unsigned)SEQ;
#pragma unroll
                for (int i = 0; i < 4; ++i) { const bool ok = okk && ((unsigned)(jb + dl0 - i) <= 256u);
                    const float p = ok ? __expf(s[nt][i] - mx[i]) : 0.f; sum[i] += p;
                    *(LAS bf16_t*)(Pw + (4 * g + i) * RS128 + (16 * nt + cl) * 2) = (bf16_t)f2bf(p); }
            }
            const unsigned uVb = uVs + (unsigned)(kb * 128 * RS64);
#pragma unroll
            for (int ks = 0; ks < 4; ++ks) {
                const bf16x8 a = frag_row(Pw, RS128, 0, 32 * ks, lane);
#pragma unroll
                for (int nt = 0; nt < 4; ++nt) o[nt] = MFMA16(a, frag_tr(uVb, RS64, 32 * ks, 16 * nt, lane), o[nt]);
            }
        }
#pragma unroll
        for (int i = 0; i < 4; ++i) { float sm = sum[i]; sm += __shfl_xor(sm, 1); sm += __shfl_xor(sm, 2); sm += __shfl_xor(sm, 4); sm += __shfl_xor(sm, 8);
            const float inv = 1.0f / (sm + __expf(sk - mx[i]));
#pragma unroll
            for (int nt = 0; nt < 4; ++nt) YC[(tq + 4 * g + i) * DM + 512 + qh * 64 + 16 * nt + cl] = (bf16_t)f2bf(o[nt][i] * inv); }
    }
}
constexpr int RS256 = 528;
__device__ __forceinline__ void b1_fft_stage1(const Frame& F) {
    const bf16_t* XB = (const bf16_t*)(F.ws + WS_XB);
    const bf16_t* TAB = (const bf16_t*)(F.ws + WS_FFT1);
    bf16_t* A1 = (bf16_t*)(F.ws + WS_SCR + SC_A1);
    const ldsp Ts = F.lds, Xs = F.lds + 128 * RS64;
    const unsigned uXs = tr_lane_base(F.lds_u32 + 128 * RS64, RS256, F.lane);
    const int lane = F.lane, w = F.wave, g = lane >> 4, cl = lane & 15;
    for (int u = F.vcu; u < 2048; u += F.G) {
        const int b = u >> 8, n2 = (u >> 2) & 63, cb = u & 3;
        __syncthreads();
        stage_tile<128, 8>(Ts, RS64, (const unsigned char*)(TAB + (size_t)n2 * 8192), 128, F.tid);
        stage_tile<64, 32>(Xs, RS256, (const unsigned char*)(XB + ((size_t)b * SEQ + n2) * DM + cb * 256), (size_t)64 * DM * 2, F.tid);
        __syncthreads();
        f32x4 acc[16];
#pragma unroll
        for (int i = 0; i < 16; ++i) acc[i] = (f32x4){0.f, 0.f, 0.f, 0.f};
#pragma unroll
        for (int ks = 0; ks < 2; ++ks) {
            const bf16x8 a = frag_row(Ts, RS64, 16 * w, 32 * ks, lane);
#pragma unroll
            for (int nt = 0; nt < 16; ++nt) acc[nt] = MFMA16(a, frag_tr(uXs, RS256, 32 * ks, 16 * nt, lane), acc[nt]);
        }
#pragma unroll
        for (int i = 0; i < 4; ++i) {
            const int r = 16 * w + 4 * g + i, ri = r >> 6, k1 = r & 63;
            bf16_t* dst = A1 + ((((size_t)b * 64 + k1) * 2 + ri) * 64 + n2) * DM + cb * 256;
#pragma unroll
            for (int nt = 0; nt < 16; ++nt) dst[16 * nt + cl] = (bf16_t)f2bf(acc[nt][i]);
        }
    }
}
__device__ __forceinline__ void b2_fft_stage2(const Frame& F) {
    const bf16_t* A1 = (const bf16_t*)(F.ws + WS_SCR + SC_A1);
    const bf16_t* GT = (const bf16_t*)(F.ws + WS_FFT2);
    bf16_t* V2 = (bf16_t*)(F.ws + WS_SCR + SC_V2);
    const ldsp Gs = F.lds, Xs = F.lds + 128 * RS128;
    const unsigned uXs = tr_lane_base(F.lds_u32 + 128 * RS128, RS256, F.lane);
    const int lane = F.lane, w = F.wave, g = lane >> 4, cl = lane & 15;
    for (int u = F.vcu; u < 2048; u += F.G) {
        const int b = u >> 8, k1 = (u >> 2) & 63, cb = u & 3;
        __syncthreads();
        stage_tile<128, 16>(Gs, RS128, (const unsigned char*)GT, 256, F.tid);
        stage_tile<128, 32>(Xs, RS256, (const unsigned char*)(A1 + ((size_t)b * 64 + k1) * 128 * DM + cb * 256), (size_t)DM * 2, F.tid);
        __syncthreads();
        f32x4 acc[16];
#pragma unroll
        for (int i = 0; i < 16; ++i) acc[i] = (f32x4){0.f, 0.f, 0.f, 0.f};
#pragma unroll
        for (int ks = 0; ks < 4; ++ks) {
            const bf16x8 a = frag_row(Gs, RS128, 16 * w, 32 * ks, lane);
#pragma unroll
            for (int nt = 0; nt < 16; ++nt) acc[nt] = MFMA16(a, frag_tr(uXs, RS256, 32 * ks, 16 * nt, lane), acc[nt]);
        }
#pragma unroll
        for (int i = 0; i < 4; ++i) {
            const int r = 16 * w + 4 * g + i, ri = r >> 6, k2 = r & 63;
            bf16_t* dst = V2 + ((size_t)b * SEQ + k1 + 64 * k2) * 2048 + ri * 1024 + cb * 256;
#pragma unroll
            for (int nt = 0; nt < 16; ++nt) dst[16 * nt + cl] = (bf16_t)f2bf(acc[nt][i]);
        }
    }
}
__device__ __forceinline__ void m1_ln_router(const Frame& F, const Args& a, int L) {
    const float* YP = (const float*)(F.ws + WS_SCR + SC_YPRE);
    bf16_t* X1 = (bf16_t*)(F.ws + WS_X1B);
    const float* WR = (const float*)(F.ws + WS_WRT) + (size_t)L * 36 * 1024;
    const float* gain = a.in[I_LN1G] + L * DM; const float* bias = a.in[I_LN1B] + L * DM;
    const float* cb = a.in[I_RCB] + L * 4; const float* fb = a.in[I_RFB] + L * 32;
    int* TOKE = (int*)(F.ws + WS_ROUTE + RT_TOKE); float* TOKG = (float*)(F.ws + WS_ROUTE + RT_TOKG); int* TOKR = (int*)(F.ws + WS_ROUTE + RT_TOKR);
    int* BCNT = (int*)(F.ws + WS_ROUTE + RT_BCNT);
    LAS float* part = (LAS float*)(F.lds + F.wave * (64 * 37 * 4));
    LAS float* lg = (LAS float*)(F.lds + 8 * 64 * 37 * 4 + F.wave * 256);
    LAS int* se = (LAS int*)(F.lds + 8 * 64 * 37 * 4 + 8 * 256);
    LAS float* sg = (LAS float*)(se + 256);
    LAS int* sr = (LAS int*)(sg + 256);
    const int lane = F.lane;
    f32x4 gn[4], bs[4];
#pragma unroll
    for (int j = 0; j < 4; ++j) { gn[j] = *(const f32x4*)(gain + 4 * lane + 256 * j); bs[j] = *(const f32x4*)(bias + 4 * lane + 256 * j); }
    for (int blk = F.vcu; blk < NT / 128; blk += F.G) {
        __syncthreads();
#pragma unroll 1
        for (int tt = 0; tt < 16; ++tt) {
            const int tl = F.wave * 16 + tt; const size_t t = (size_t)blk * 128 + tl;
            f32x4 v[4]; float s = 0.f;
#pragma unroll
            for (int j = 0; j < 4; ++j) { v[j] = *(const f32x4*)(YP + t * DM + 4 * lane + 256 * j); s += (v[j][0] + v[j][1]) + (v[j][2] + v[j][3]); }
            const float mean = wave_sum(s) * (1.0f / DM); float q = 0.f;
#pragma unroll
            for (int j = 0; j < 4; ++j) { v[j] = v[j] - mean; q += (v[j][0] * v[j][0] + v[j][1] * v[j][1]) + (v[j][2] * v[j][2] + v[j][3] * v[j][3]); }
            const float rstd = 1.0f / sqrtf(wave_sum(q) * (1.0f / DM) + LN_EPS);
#pragma unroll
            for (int j = 0; j < 4; ++j) { v[j] = v[j] * rstd * gn[j] + bs[j]; u32x2 o; o.x = pk2(v[j][0], v[j][1]); o.y = pk2(v[j][2], v[j][3]); *(u32x2*)(X1 + t * DM + 4 * lane + 256 * j) = o; }
#pragma unroll 4
            for (int o = 0; o < 36; ++o) {
                float p = 0.f;
#pragma unroll
                for (int j = 0; j < 4; ++j) { const f32x4 wv = *(const f32x4*)(WR + o * 1024 + 4 * lane + 256 * j); p += (v[j][0] * wv[0] + v[j][1] * wv[1]) + (v[j][2] * wv[2] + v[j][3] * wv[3]); }
                part[lane * 37 + o] = p;
            }
            if (lane < 36) {
                float sum = 0.f;
#pragma unroll 8
                for (int l2 = 0; l2 < 64; ++l2) sum += part[l2 * 37 + lane];
                lg[lane] = sum + (lane < 4 ? cb[lane] : fb[lane - 4]);
            }
            if (lane == 0) {
                float c0 = lg[0]; int gi = 0;
#pragma unroll
                for (int k = 1; k < 4; ++k) { const float c = lg[k]; if (c > c0) { c0 = c; gi = k; } }
                float den = 0.f;
#pragma unroll
                for (int k = 0; k < 4; ++k) den += __expf(lg[k] - c0);
                const float pg = 1.0f / den;
                float v1 = -3.0e38f, v2 = -3.0e38f; int i1 = 0, i2 = 0;
                for (int k = 0; k < 8; ++k) { const float f = lg[4 + gi * 8 + k];
                    if (f > v1) { v2 = v1; i2 = i1; v1 = f; i1 = k; } else if (f > v2) { v2 = f; i2 = k; } }
                const float e2 = __expf(v2 - v1), g1 = pg / (1.0f + e2), g2 = pg * e2 / (1.0f + e2);
                se[2 * tl] = gi * 8 + i1; se[2 * tl + 1] = gi * 8 + i2; sg[2 * tl] = g1; sg[2 * tl + 1] = g2;
            }
        }
        __syncthreads();
        LAS int* cn = sr + 256;
        if (F.tid < 32) cn[F.tid] = 0;
        __syncthreads();
        if (F.tid == 0) { for (int i = 0; i < 256; ++i) { const int e = se[i]; const int r = cn[e]; sr[i] = r; cn[e] = r + 1; } }
        __syncthreads();
        if (F.tid < 256) { const size_t ai = (size_t)blk * 256 + F.tid; TOKE[ai] = se[F.tid]; TOKG[ai] = sg[F.tid]; TOKR[ai] = sr[F.tid]; }
        if (F.tid < 32) BCNT[blk * 32 + F.tid] = cn[F.tid];
    }
}
__device__ __forceinline__ void m2_scatter(const Frame& F) {
    const int* TOKE = (const int*)(F.ws + WS_ROUTE + RT_TOKE); const float* TOKG = (const float*)(F.ws + WS_ROUTE + RT_TOKG); const int* TOKR = (const int*)(F.ws + WS_ROUTE + RT_TOKR);
    int* TOKP = (int*)(F.ws + WS_ROUTE + RT_TOKP); const int* BCNT = (const int*)(F.ws + WS_ROUTE + RT_BCNT);
    float* SGATE = (float*)(F.ws + WS_ROUTE + RT_SGATE); int* TILEE = (int*)(F.ws + WS_ROUTE + RT_TILEE);
    const bf16_t* X1 = (const bf16_t*)(F.ws + WS_X1B); bf16_t* XS = (bf16_t*)(F.ws + WS_SCR + SC_XS);
    LAS int* pre = (LAS int*)F.lds; LAS int* tot = pre + 32; LAS int* start = tot + 32; LAS int* pos = start + 32;
    for (int blk = F.vcu; blk < NT / 128; blk += F.G) {
        __syncthreads();
        if (F.tid < 32) { int p = 0, tt = 0; for (int b2 = 0; b2 < NT / 128; ++b2) { const int c = BCNT[b2 * 32 + F.tid]; if (b2 < blk) p += c; tt += c; } pre[F.tid] = p; tot[F.tid] = tt; }
        __syncthreads();
        if (F.tid == 0) {
            int st = 0;
            for (int e = 0; e < 32; ++e) { start[e] = st; const int nt_e = (tot[e] + 255) >> 8;
                if (blk == 0) for (int k = 0; k < nt_e; ++k) TILEE[(st >> 8) + k] = e;
                st += nt_e << 8; }
            if (blk == 0) TILEE[320] = st >> 8;
        }
        __syncthreads();
        if (F.tid < 256) { const size_t ai = (size_t)blk * 256 + F.tid; const int e = TOKE[ai]; const int p = start[e] + pre[e] + TOKR[ai]; pos[F.tid] = p; TOKP[ai] = p; SGATE[p] = TOKG[ai]; }
        __syncthreads();
#pragma unroll 1
        for (int r = F.wave; r < 256; r += 8) {
            const size_t t = (size_t)blk * 128 + (r >> 1); const int p = pos[r];
            const u32x4* src = (const u32x4*)(X1 + t * DM); u32x4* dst = (u32x4*)(XS + (size_t)p * DM);
            dst[F.lane] = src[F.lane]; dst[F.lane + 64] = src[F.lane + 64];
        }
    }
}
__device__ __forceinline__ void m5_combine_ln(const Frame& F, const Args& a, int L) {
    const bf16_t* X1 = (const bf16_t*)(F.ws + WS_X1B); const bf16_t* YS = (const bf16_t*)(F.ws + WS_SCR + SC_YS);
    const int* TOKP = (const int*)(F.ws + WS_ROUTE + RT_TOKP);
    bf16_t* XB = (bf16_t*)(F.ws + WS_XB);
    const float* gain = a.in[I_LN2G] + L * DM; const float* bias = a.in[I_LN2B] + L * DM;
    const int lane = F.lane;
    f32x4 gn[4], bs[4];
#pragma unroll
    for (int j = 0; j < 4; ++j) { gn[j] = *(const f32x4*)(gain + 4 * lane + 256 * j); bs[j] = *(const f32x4*)(bias + 4 * lane + 256 * j); }
    for (int t = F.vcu * 8 + F.wave; t < NT; t += F.G * 8) {
        const int p0 = TOKP[2 * t], p1 = TOKP[2 * t + 1];
        f32x4 v[4]; float s = 0.f;
#pragma unroll
        for (int j = 0; j < 4; ++j) {
            const u32x2 x = *(const u32x2*)(X1 + (size_t)t * DM + 4 * lane + 256 * j);
            const u32x2 y0 = *(const u32x2*)(YS + (size_t)p0 * DM + 4 * lane + 256 * j);
            const u32x2 y1 = *(const u32x2*)(YS + (size_t)p1 * DM + 4 * lane + 256 * j);
            v[j][0] = ALPHA * bf_lo(x.x) + (bf_lo(y0.x) + bf_lo(y1.x)); v[j][1] = ALPHA * bf_hi(x.x) + (bf_hi(y0.x) + bf_hi(y1.x));
            v[j][2] = ALPHA * bf_lo(x.y) + (bf_lo(y0.y) + bf_lo(y1.y)); v[j][3] = ALPHA * bf_hi(x.y) + (bf_hi(y0.y) + bf_hi(y1.y));
            s += (v[j][0] + v[j][1]) + (v[j][2] + v[j][3]);
        }
        const float mean = wave_sum(s) * (1.0f / DM); float q = 0.f;
#pragma unroll
        for (int j = 0; j < 4; ++j) { v[j] = v[j] - mean; q += (v[j][0] * v[j][0] + v[j][1] * v[j][1]) + (v[j][2] * v[j][2] + v[j][3] * v[j][3]); }
        const float rstd = 1.0f / sqrtf(wave_sum(q) * (1.0f / DM) + LN_EPS);
#pragma unroll
        for (int j = 0; j < 4; ++j) {
            v[j] = v[j] * rstd * gn[j] + bs[j];
            u32x2 o; o.x = pk2(v[j][0], v[j][1]); o.y = pk2(v[j][2], v[j][3]); *(u32x2*)(XB + (size_t)t * DM + 4 * lane + 256 * j) = o;
            if (L == DEPTH - 1) *(f32x4*)(a.out + (size_t)t * DM + 4 * lane + 256 * j) = v[j];
        }
    }
}

__global__ void __launch_bounds__(512, 2) fwd_kernel(Args args) {
    extern __shared__ __attribute__((aligned(16))) unsigned char lds_raw[];
    Frame F;
    F.lds = (ldsp)lds_raw; F.lds_u32 = (unsigned)(size_t)lds_raw;
    F.tid = threadIdx.x; F.lane = F.tid & 63; F.wave = __builtin_amdgcn_readfirstlane(F.tid >> 6);
    F.G = gridDim.x; { const int bx = blockIdx.x; F.vcu = (F.G % 8 == 0) ? (bx % 8) * (F.G / 8) + bx / 8 : bx; }
    F.ws = args.ws;
    volatile LAS unsigned* MISC = (volatile LAS unsigned*)(F.lds + MISC_OFF);
    if (F.tid < 64) MISC[F.tid] = 0u;
    __syncthreads();
    XcdBarrier bar; bar.bar = (unsigned*)(args.ws + WS_CTL) + CW_BAR; bar.x = 0; bar.st = nullptr;
    const int lo = args.ph_lo, hi = args.ph_hi;
    if (hi - lo > 1) bar = xcd_barrier_post((unsigned*)(args.ws + WS_CTL) + CW_BAR, MISC + 8);
    int ph = 0;
#ifndef PH_MASK
#define PH_MASK 0xffffffffu
#endif
#define PH_BEGIN(id) if (((PH_MASK >> (id)) & 1u) && ph >= lo && ph < hi) { unsigned char* ws = args.ws; asm volatile("" : "+s"(ws)); Frame FL = F; FL.ws = ws; { int t_ = F.tid; asm volatile("" : "+v"(t_)); FL.tid = t_; FL.lane = t_ & 63; FL.wave = __builtin_amdgcn_readfirstlane(t_ >> 6); unsigned l_ = F.lds_u32; asm volatile("" : "+s"(l_)); FL.lds_u32 = l_; FL.lds = (ldsp)(uintptr_t)l_; }
#define PH_END   if (ph + 1 < hi) xcd_barrier(bar); } ++ph;
    const int bid = (int)blockIdx.x;

    PH_BEGIN(0) p0a_prologue(FL, args); PH_END
    PH_BEGIN(1) {
        pg8::WppOrder S{(const char*)(ws + WS_WFO), (const char*)(ws + WS_CHDFT), F.G, bid};
        pg8::EpiWpp E{(bf16_t*)(ws + WS_WPP)};
        pg8::gemm_phase<pg8::EpiWpp, pg8::WppOrder, true>(FL.lds, FL.tid, 1024, 256, 256, S, E);
    } PH_END

#pragma unroll 1
    for (int L = 0; L < DEPTH; ++L) {
        const int e = L >> 1;
        if ((L & 1) == 0) {
            PH_BEGIN(2) {
                pg8::DenseOrder S{(const char*)(ws + WS_XB), (const char*)(ws + WS_WIN) + (size_t)e * IN_EVEN * 1024 * 2, 1024, 1024, NT / 256, IN_EVEN / 256, F.G, bid};
                pg8::EpiInProj E{(bf16_t*)(ws + WS_SCR + SC_H), (const f32x2*)(ws + WS_ROPE64), (const f32x2*)(ws + WS_ROPE32)};
                pg8::gemm_phase<pg8::EpiInProj, pg8::DenseOrder, true>(FL.lds, FL.tid, 1024, 1024, 1024, S, E);
            } PH_END
            PH_BEGIN(3) a2_ret_states(FL, args.in[I_DECAY] + e * 8); PH_END
            PH_BEGIN(4) a3_ret_scan(FL, args.in[I_DECAY] + e * 8); PH_END
            PH_BEGIN(5) {
                for (int u = F.vcu; u < 1024; u += F.G) a4_ret_unit(FL, u, args.in[I_DECAY] + e * 8, args.in[I_GN] + e * 512);
                for (int u = F.vcu; u < 512; u += F.G) a4_win_unit(FL, u, args.in[I_SINK] + e * 8);
            } PH_END
            PH_BEGIN(6) {
                pg8::DenseOrder S{(const char*)(ws + WS_SCR + SC_YCAT), (const char*)(ws + WS_WOUT) + (size_t)e * 1024 * 1024 * 2, 1024, 1024, NT / 256, 4, F.G, bid};
                pg8::EpiResid E{(const bf16_t*)(ws + WS_XB), (float*)(ws + WS_SCR + SC_YPRE)};
                pg8::gemm_phase<pg8::EpiResid, pg8::DenseOrder, true>(FL.lds, FL.tid, 1024, 1024, 1024, S, E);
            } PH_END
        } else {
            PH_BEGIN(7) b1_fft_stage1(FL); PH_END
            PH_BEGIN(8) b2_fft_stage2(FL); PH_END
            PH_BEGIN(9) {
                pg8::DenseOrder S{(const char*)(ws + WS_SCR + SC_V2), (const char*)(ws + WS_WPP) + (size_t)e * 1024 * 2048 * 2, 2048, 2048, NT / 256, 4, F.G, bid};
                pg8::EpiResid E{(const bf16_t*)(ws + WS_XB), (float*)(ws + WS_SCR + SC_YPRE)};
                pg8::gemm_phase<pg8::EpiResid, pg8::DenseOrder, true>(FL.lds, FL.tid, 2048, 2048, 2048, S, E);
            } PH_END
        }
        PH_BEGIN(10) m1_ln_router(FL, args, L); PH_END
        PH_BEGIN(11) m2_scatter(FL); PH_END
        PH_BEGIN(12) {
            const int* tile_e = (const int*)(ws + WS_ROUTE + RT_TILEE);
            const int ntiles = __builtin_amdgcn_readfirstlane(tile_e[320]);
            pg8::GroupedOrder S{(const char*)(ws + WS_SCR + SC_XS), (const char*)(ws + WS_WGU) + (size_t)L * 32 * 1024 * 1024 * 2, tile_e, (size_t)1024 * 1024 * 2, 1024, 1024, ntiles, 4, F.G, bid};
            pg8::EpiGateUp E{(bf16_t*)(ws + WS_SCR + SC_HID)};
            pg8::gemm_phase<pg8::EpiGateUp, pg8::GroupedOrder, true>(FL.lds, FL.tid, 1024, 1024, 1024, S, E);
        } PH_END
        PH_BEGIN(13) {
            const int* tile_e = (const int*)(ws + WS_ROUTE + RT_TILEE);
            const int ntiles = __builtin_amdgcn_readfirstlane(tile_e[320]);
            pg8::GroupedOrder S{(const char*)(ws + WS_SCR + SC_HID), (const char*)(ws + WS_WD) + (size_t)L * 32 * 1024 * EH * 2, tile_e, (size_t)1024 * EH * 2, EH, EH, ntiles, 4, F.G, bid};
            pg8::EpiDown E{(bf16_t*)(ws + WS_SCR + SC_YS), (const float*)(ws + WS_ROUTE + RT_SGATE)};
            pg8::gemm_phase<pg8::EpiDown, pg8::GroupedOrder, true>(FL.lds, FL.tid, EH, EH, EH, S, E);
        } PH_END
        PH_BEGIN(14) m5_combine_ln(FL, args, L); PH_END
    }
#undef PH_BEGIN
#undef PH_END
}
constexpr int N_PHASES = 2 + 2 * 5 + 2 * 3 + 4 * 5;

extern "C" void kernel_launch(void* const* d_in, const int* in_sizes, int n_in, void* d_out, int out_size, void* d_ws, size_t ws_size, hipStream_t stream) {
    static int grid = 0;
    if (grid == 0) {
        if (n_in != 18 || out_size != NT * DM || ws_size < WS_END) { fprintf(stderr, "kernel_launch: unexpected shapes (n_in %d out %d ws %zu, need %zu)\n", n_in, out_size, ws_size, (size_t)WS_END); grid = -1; return; }
        int dev = 0, cus = 0, per_cu = 0;
        hipGetDevice(&dev); hipDeviceGetAttribute(&cus, hipDeviceAttributeMultiprocessorCount, dev);
        if (hipFuncSetAttribute((const void*)fwd_kernel, hipFuncAttributeMaxDynamicSharedMemorySize, LDS_BYTES) != hipSuccess) { fprintf(stderr, "kernel_launch: hipFuncSetAttribute failed\n"); grid = -1; return; }
        hipOccupancyMaxActiveBlocksPerMultiprocessor(&per_cu, (const void*)fwd_kernel, 512, LDS_BYTES);
        (void)hipGetLastError();
        if (per_cu < 1) fprintf(stderr, "kernel_launch: occupancy query says %d blocks/CU\n", per_cu);
        grid = cus > 0 ? cus : 256;
    }
    if (grid < 0) return;
    hipMemsetAsync((char*)d_ws + WS_CTL, 0, CTL_BYTES, stream);
    Args a{};
    for (int i = 0; i < 18; ++i) a.in[i] = (const float*)d_in[i];
    a.out = (float*)d_out; a.ws = (unsigned char*)d_ws;
#if N_LAUNCH_MODE == 1
    a.ph_lo = 0; a.ph_hi = N_PHASES;
    void* kargs[] = {&a};
    hipError_t le = hipLaunchCooperativeKernel((const void*)fwd_kernel, dim3(grid), dim3(512), kargs, LDS_BYTES, stream);
    if (le != hipSuccess) fprintf(stderr, "kernel_launch: cooperative launch failed: %s\n", hipGetErrorName(le));
#else
    for (int p = 0; p < N_PHASES; ++p) {
        a.ph_lo = p; a.ph_hi = p + 1;
        hipLaunchKernelGGL(fwd_kernel, dim3(grid), dim3(512), LDS_BYTES, stream, a);
    }
#endif
}
```

```cpp
#include <hip/hip_runtime.h>
#include <cstdio>
#include <cstdint>

#ifndef N_LAUNCH_MODE
#define N_LAUNCH_MODE 1
#endif

#define LAS __attribute__((address_space(3)))
typedef unsigned short bf16_t;
typedef short bf16x8 __attribute__((ext_vector_type(8)));
typedef short bf16x4 __attribute__((ext_vector_type(4)));
typedef float f32x4 __attribute__((ext_vector_type(4)));
typedef float f32x2 __attribute__((ext_vector_type(2)));
typedef unsigned u32x4 __attribute__((ext_vector_type(4)));
typedef unsigned u32x2 __attribute__((ext_vector_type(2)));
typedef LAS unsigned char* ldsp;

constexpr int NB = 8, SEQ = 4096, DM = 1024, NT = NB * SEQ, DEPTH = 4;
constexpr int IN_EVEN = 2816;
constexpr int C_QA = 0, C_KA = 512, C_VA = 1024, C_GA = 1536, C_QB = 2048, C_KB = 2560, C_VB = 2688;
constexpr int NEXP = 32, EH = 512;
constexpr int RMAX = 65536 + 32 * 256;
constexpr float LN_EPS = 1e-5f, GN_EPS = 1e-6f;
constexpr float ALPHA = 1.681792830507429f;

constexpr size_t MiB = 1u << 20;
constexpr size_t WS_CTL = 0, CTL_BYTES = 1 * MiB;
constexpr size_t WS_ROPE64 = 1 * MiB;
constexpr size_t WS_ROPE32 = 3 * MiB;
constexpr size_t WS_FFT1 = 4 * MiB;
constexpr size_t WS_FFT2 = 5 * MiB;
constexpr size_t WS_CHDFT = 5 * MiB + 65536;
constexpr size_t WS_WRT = 6 * MiB;
constexpr size_t WS_ROUTE = 8 * MiB;
constexpr size_t WS_WIN = 12 * MiB;
constexpr size_t WS_WOUT = 23 * MiB;
constexpr size_t WS_WFO = 27 * MiB;
constexpr size_t WS_WPP = 31 * MiB;
constexpr size_t WS_WGU = 39 * MiB;
constexpr size_t WS_WD = 295 * MiB;
constexpr size_t WS_XB = 423 * MiB;
constexpr size_t WS_X1B = 487 * MiB;
constexpr size_t WS_SCR = 551 * MiB;
constexpr size_t WS_END = 951 * MiB;
constexpr size_t SC_H = 0;
constexpr size_t SC_KV = 176 * MiB;
constexpr size_t SC_RT = 304 * MiB;
constexpr size_t SC_YCAT = 176 * MiB;
constexpr size_t SC_YPRE = 0;
constexpr size_t SC_A1 = 0;
constexpr size_t SC_V2 = 128 * MiB;
constexpr size_t SC_XS = 0;
constexpr size_t SC_HID = 144 * MiB;
constexpr size_t SC_YS = 216 * MiB;
constexpr size_t RT_TOKE = 0;
constexpr size_t RT_TOKG = 256 * 1024;
constexpr size_t RT_TOKR = 512 * 1024;
constexpr size_t RT_TOKP = 768 * 1024;
constexpr size_t RT_BCNT = 1024 * 1024;
constexpr size_t RT_SGATE = 1024 * 1024 + 65536;
constexpr size_t RT_TILEE = 2048 * 1024;
constexpr size_t RT_STOK = 2560 * 1024;
constexpr int CW_BAR = 4096;

constexpr int LDS_BYTES = 155648;
constexpr int MISC_OFF = 151552;

__device__ __forceinline__ unsigned f2bf(float f) { unsigned u = __builtin_bit_cast(unsigned, f); return (u + 0x7fffu + ((u >> 16) & 1u)) >> 16; }
__device__ __forceinline__ unsigned pk2(float lo, float hi) { return f2bf(lo) | (f2bf(hi) << 16); }
__device__ __forceinline__ float bf_lo(unsigned u) { return __builtin_bit_cast(float, u << 16); }
__device__ __forceinline__ float bf_hi(unsigned u) { return __builtin_bit_cast(float, u & 0xffff0000u); }
__device__ __forceinline__ float bf2f(bf16_t h) { return __builtin_bit_cast(float, (unsigned)h << 16); }
__device__ __forceinline__ float wave_sum(float v) {
#pragma unroll
    for (int o = 1; o < 64; o <<= 1) v += __shfl_xor(v, o);
    return v;
}
__device__ __forceinline__ float silu_f(float g) { return g / (1.0f + __expf(-g)); }

__device__ __forceinline__ void sincos_turn(double frac, double& s, double& c) {
    const double r = frac * 6.283185307179586 * 0.125;
    const double r2 = r * r;
    double sp = 1.0 / 6227020800.0;
    sp = sp * r2 * -1.0 + 1.0 / 39916800.0; sp = sp * r2 * -1.0 + 1.0 / 362880.0; sp = sp * r2 * -1.0 + 1.0 / 5040.0; sp = sp * r2 * -1.0 + 1.0 / 120.0; sp = sp * r2 * -1.0 + 1.0 / 6.0; sp = sp * r2 * -1.0 + 1.0;
    double ss = sp * r;
    double cp = 1.0 / 479001600.0;
    cp = cp * r2 * -1.0 + 1.0 / 3628800.0; cp = cp * r2 * -1.0 + 1.0 / 40320.0; cp = cp * r2 * -1.0 + 1.0 / 720.0; cp = cp * r2 * -1.0 + 1.0 / 24.0; cp = cp * r2 * -1.0 + 0.5; cp = cp * r2 * -1.0 + 1.0;
    double cc = cp;
#pragma unroll
    for (int i = 0; i < 3; ++i) { const double s2 = 2.0 * ss * cc, c2 = cc * cc - ss * ss; ss = s2; cc = c2; }
    s = ss; c = cc;
}
__device__ __forceinline__ void sincos_frac(int p, int N, double& s, double& c) {
    p %= N; if (p < 0) p += N; if (2 * p >= N) p -= N;
    sincos_turn((double)p / (double)N, s, c);
}

#define XB_TMO      128
#define XB_XCNT(j)  (256  + 64 * (j))
#define XB_XSUB(j)  (1280 + 64 * (j))
#define XB_XGEN(j)  (2304 + 64 * (j))
#define XB_TOP      3328
#define XB_TOPGEN   3392
#define XCD_BAR_WORDS 3456
#define XB_SPIN_CAP (1u << 20)
__device__ __forceinline__ unsigned xb_ld(unsigned* p)              { return __hip_atomic_load(p, __ATOMIC_RELAXED, __HIP_MEMORY_SCOPE_AGENT); }
__device__ __forceinline__ unsigned xb_add(unsigned* p, unsigned v) { return __hip_atomic_fetch_add(p, v, __ATOMIC_RELAXED, __HIP_MEMORY_SCOPE_AGENT); }
__device__ __forceinline__ unsigned xb_xcc_id() { return (unsigned)__builtin_amdgcn_s_getreg((3 << 11) | 20) & 0xFu; }
#define XB_SPIN(cond, bar) do { unsigned _sp = 0; while (cond) { __builtin_amdgcn_s_sleep(1); \
    if ((++_sp & 255u) == 0u) { if (xb_ld(&(bar)[XB_TMO])) break; if (_sp > XB_SPIN_CAP) { atomicAdd(&(bar)[XB_TMO], 1u); break; } } } } while (0)
struct XcdBarrier { unsigned* bar; unsigned x; volatile LAS unsigned* st; };
__device__ __forceinline__ XcdBarrier xcd_barrier_post(unsigned* bar, volatile LAS unsigned* st) {
    XcdBarrier b; b.bar = bar; b.x = xb_xcc_id(); b.st = st;
    if (threadIdx.x == 0) (void)xb_add(&bar[XB_XCNT(b.x)], 1u);
    return b;
}
__device__ __forceinline__ void xcd_barrier_complete(unsigned* bar, unsigned x, unsigned& nloc, unsigned& nx) {
    const unsigned G = gridDim.x * gridDim.y * gridDim.z;
    unsigned sum, cnt, mine, sp = 0u;
    for (;;) {
        sum = 0u; cnt = 0u; mine = 0u;
#pragma unroll
        for (unsigned j = 0; j < 16; ++j) { const unsigned c = xb_ld(&bar[XB_XCNT(j)]); sum += c; cnt += (c > 0u) ? 1u : 0u; mine = (j == x) ? c : mine; }
        if (sum == G) break;
        __builtin_amdgcn_s_sleep(1);
        if ((++sp & 255u) == 0u) { if (xb_ld(&bar[XB_TMO])) break; if (sp > XB_SPIN_CAP) { atomicAdd(&bar[XB_TMO], 1u); break; } }
    }
    nloc = mine > 0u ? mine : 1u; nx = cnt > 0u ? cnt : 1u;
}
__device__ __forceinline__ void xcd_barrier(const XcdBarrier& b) {
    asm volatile("s_waitcnt vmcnt(0)" ::: "memory");
    __syncthreads();
    if (threadIdx.x == 0) {
        unsigned* bar = b.bar;
        __builtin_amdgcn_s_waitcnt(0);
        unsigned nloc = b.st[0], nx = b.st[1];
        if (nloc == 0u) { xcd_barrier_complete(bar, b.x, nloc, nx); b.st[0] = nloc; b.st[1] = nx; }
        const unsigned old = xb_add(&bar[XB_XSUB(b.x)], 1u);
        const unsigned gen = old / nloc;
        if (old + 1u == (gen + 1u) * nloc) {
            __builtin_amdgcn_fence(__ATOMIC_RELEASE, "agent");
            asm volatile("s_waitcnt vmcnt(0)" ::: "memory");
            const unsigned og = xb_add(&bar[XB_TOP], 1u);
            const unsigned tg = og / nx;
            if (og + 1u == (tg + 1u) * nx) xb_add(&bar[XB_TOPGEN], 1u);
            else XB_SPIN(xb_ld(&bar[XB_TOPGEN]) == tg, bar);
            __builtin_amdgcn_fence(__ATOMIC_ACQUIRE, "agent");
            xb_add(&bar[XB_XGEN(b.x)], 1u);
            asm volatile("s_waitcnt vmcnt(0)" ::: "memory");
        } else {
            XB_SPIN(xb_ld(&bar[XB_XGEN(b.x)]) == gen, bar);
            __builtin_amdgcn_fence(__ATOMIC_ACQUIRE, "agent");
            asm volatile("s_waitcnt vmcnt(0)" ::: "memory");
        }
    }
    __syncthreads();
}

namespace pg8 {
constexpr int BM = 256, BK = 64, HALF = 128, HTB = HALF * BK * 2, STAGE_BYTES = 8 * HTB, NXCD = 8, WGM = 8;
__host__ __device__ __forceinline__ int lds_byte(int r, int c) { const int st = (r >> 4) * 2 + (c >> 5), rr = r & 15, cc = c & 31, ob = rr * 64 + cc * 2; return st * 1024 + (ob ^ (((ob >> 9) & 1) << 5)); }
__host__ __device__ __forceinline__ void stage_rc(int b, int& R, int& C) { const int st = b / 1024, sb = b % 1024, swz = sb ^ (((sb >> 9) & 1) << 5); R = (st >> 1) * 16 + swz / 64; C = (st & 1) * 32 + (swz % 64) / 2; }
__host__ __device__ __forceinline__ int perm32(int rho) { const int n = rho >> 4, i = rho & 15; return 8 * (i >> 2) + 4 * n + (i & 3); }

struct Unit { int pm, pn, tag, pad; const char* a; const char* b; const int* gi; };

__device__ __forceinline__ bool static_order(int i, int G, int c, int nM, int nN, int& pm, int& pn) {
    const int nwg = nM * nN; const long L = (long)i * G + c; if (L >= nwg) return false;
    int wgid = (int)L; { const int q = nwg / NXCD, r = nwg % NXCD, xcd = wgid % NXCD, off = wgid / NXCD; wgid = (xcd < r ? xcd * (q + 1) : r * (q + 1) + (xcd - r) * q) + off; }
    const int nig = WGM * nN, gid = wgid / nig, fm = gid * WGM, gsz = (nM - fm) < WGM ? (nM - fm) : WGM;
    pm = fm + ((wgid % nig) % gsz); pn = (wgid % nig) / gsz; return true;
}
struct DenseOrder {
    static constexpr bool GATHER = false;
    const char* A; const char* Bt; int lda, ldb, nM, nN, G, c;
    __device__ __forceinline__ bool next(int i, Unit& u) const {
        if (!static_order(i, G, c, nM, nN, u.pm, u.pn)) return false;
        u.tag = 0; u.pad = 0; u.gi = nullptr; u.a = A + (size_t)u.pm * BM * lda * 2; u.b = Bt + (size_t)u.pn * BM * ldb * 2; return true;
    }
};
template <bool GATH>
struct GroupedOrder {
    static constexpr bool GATHER = GATH;
    const char* A; const char* W; const int* tile_e; const int* rowidx; size_t estride; int lda, ldb, nM, nN, G, c;
    __device__ __forceinline__ bool next(int i, Unit& u) const {
        if (!static_order(i, G, c, nM, nN, u.pm, u.pn)) return false;
        const int e = __builtin_amdgcn_readfirstlane(tile_e[u.pm]);
        u.tag = e; u.pad = 0; u.b = W + (size_t)e * estride + (size_t)u.pn * BM * ldb * 2;
        if (GATH) { u.a = A; u.gi = rowidx + (size_t)u.pm * BM; } else { u.a = A + (size_t)u.pm * BM * lda * 2; u.gi = nullptr; }
        return true;
    }
};

__device__ __forceinline__ unsigned cvt_pk_bf16(float lo, float hi) { unsigned r; asm volatile("v_cvt_pk_bf16_f32 %0, %1, %2" : "=v"(r) : "v"(lo), "v"(hi)); return r; }

template <class Epi, class Sched, bool ALIGN_EPI>
__device__ __forceinline__ void gemm_phase(ldsp lds, const int tid, const int lda, const int ldb, const int K, const Sched& S, const Epi& E) {
    const int wid = __builtin_amdgcn_readfirstlane(tid >> 6), lane = tid & 63, wr = wid >> 2, wc = wid & 3, fr = lane & 15, fq = lane >> 4;
    const int nt = K / BK;
    constexpr bool GA = Sched::GATHER;
    unsigned voffA[2], voffB[2]; int gR[2], gC[2];
#pragma unroll
    for (int i = 0; i < 2; ++i) { int R, C; stage_rc(tid * 16 + i * 8192, R, C); const int Rb = Epi::PERM ? ((R & ~31) + perm32(R & 31)) : R;
        voffA[i] = (unsigned)(R * lda + C) * 2u; voffB[i] = (unsigned)(Rb * ldb + C) * 2u; gR[i] = R; gC[i] = C * 2; }
    unsigned cv[2][2], nv[2][2];
#define PG8_LOADG(u_, v_) do { _Pragma("unroll") for (int h_ = 0; h_ < 2; ++h_) _Pragma("unroll") for (int i_ = 0; i_ < 2; ++i_) \
        v_[h_][i_] = (unsigned)((u_).gi[h_ * HALF + gR[i_]]) * (unsigned)(lda * 2) + (unsigned)gC[i_]; } while (0)
#define PG8_STAGE_A(bufoff, h, kptr, nx) do { if constexpr (GA) { \
        const unsigned v0_ = (nx) ? nv[h][0] : cv[h][0], v1_ = (nx) ? nv[h][1] : cv[h][1]; \
        __builtin_amdgcn_global_load_lds((const unsigned*)((const char*)(kptr) + v0_), (LAS unsigned*)(lds + (bufoff) + ldsw), 16, 0, 0); \
        __builtin_amdgcn_global_load_lds((const unsigned*)((const char*)(kptr) + v1_), (LAS unsigned*)(lds + (bufoff) + ldsw + 8192), 16, 0, 0); \
    } else { PG8_STAGE(bufoff, (kptr) + (h) * hstepA, voffA); } } while (0)
    const size_t kstep = (size_t)(BK * 2);
    const size_t hstepA = (size_t)HALF * lda * 2, hstepB = (size_t)HALF * ldb * 2;
    const unsigned ldsw = (unsigned)wid * 1024u;
    const int aoff = lds_byte(wr * 64 + fr, fq * 8), boff = lds_byte(wc * 32 + fr, fq * 8);
#define PG8_SA(b, h) (((b) * 2 + (h)) * HTB)
#define PG8_SB(b, h) ((4 + (b) * 2 + (h)) * HTB)
#define PG8_STAGE(bufoff, gbase, voff) do { _Pragma("unroll") for (int _i = 0; _i < 2; ++_i) \
        __builtin_amdgcn_global_load_lds((const unsigned*)((const char*)(gbase) + (voff)[_i]), (LAS unsigned*)(lds + (bufoff) + ldsw + _i * 8192), 16, 0, 0); } while (0)
#define PG8_LDA(dst, b, h) do { _Pragma("unroll") for (int m = 0; m < 4; ++m) _Pragma("unroll") for (int k = 0; k < 2; ++k) dst[m][k] = *(const LAS bf16x8*)(lds + PG8_SA(b, h) + aoff + m * 2048 + k * 1024); } while (0)
#define PG8_LDB(dst, b, h) do { _Pragma("unroll") for (int n = 0; n < 2; ++n) _Pragma("unroll") for (int k = 0; k < 2; ++k) dst[n][k] = *(const LAS bf16x8*)(lds + PG8_SB(b, h) + boff + n * 2048 + k * 1024); } while (0)
#define PG8_MMA(ai, bj, At, Bt) do { __builtin_amdgcn_s_setprio(1); _Pragma("unroll") for (int m = 0; m < 4; ++m) _Pragma("unroll") for (int n = 0; n < 2; ++n) _Pragma("unroll") for (int k = 0; k < 2; ++k) \
        acc[ai][bj][m][n] = __builtin_amdgcn_mfma_f32_16x16x32_bf16(Bt[n][k], At[m][k], acc[ai][bj][m][n], 0, 0, 0); __builtin_amdgcn_s_setprio(0); } while (0)
#define PG8_WAIT_V(n) asm volatile("s_waitcnt vmcnt(" #n ")" ::: "memory")
#define PG8_WAIT_L(n) asm volatile("s_waitcnt lgkmcnt(" #n ")" ::: "memory")
#define PG8_BAR __builtin_amdgcn_s_barrier()
#define PG8_SCHED __builtin_amdgcn_sched_barrier(0)
    Unit cur, nxt; int ui = 0;
    if (!S.next(0, cur)) return;
    f32x4 acc[2][2][4][2];
#pragma unroll
    for (int a = 0; a < 2; ++a)
#pragma unroll
        for (int b = 0; b < 2; ++b)
#pragma unroll
            for (int m = 0; m < 4; ++m)
#pragma unroll
                for (int n = 0; n < 2; ++n) acc[a][b][m][n] = (f32x4){0.f, 0.f, 0.f, 0.f};
    bf16x8 At[4][2], B0[2][2], B1[2][2];
    const char* cA = cur.a; const char* cB = cur.b;
    if constexpr (GA) { PG8_LOADG(cur, cv); }
#pragma unroll
    for (int h_ = 0; h_ < 2; ++h_) { nv[h_][0] = cv[h_][0]; nv[h_][1] = cv[h_][1]; }
    PG8_STAGE(PG8_SB(0, 0), cB, voffB); PG8_STAGE(PG8_SB(0, 1), cB + hstepB, voffB); PG8_STAGE_A(PG8_SA(0, 0), 0, cA, false); PG8_STAGE_A(PG8_SA(0, 1), 1, cA, false);
    if (wr == 1) PG8_BAR;
    PG8_WAIT_V(2); PG8_BAR;
    PG8_STAGE(PG8_SB(1, 0), cB + kstep, voffB); PG8_STAGE_A(PG8_SA(1, 0), 0, cA + kstep, false); PG8_STAGE(PG8_SB(1, 1), cB + hstepB + kstep, voffB);
    PG8_WAIT_V(6); PG8_BAR;
    for (;;) {
        const bool has_next = S.next(ui + 1, nxt);
        const char* nA = has_next ? nxt.a : cA; const char* nB = has_next ? nxt.b : cB;
        if constexpr (GA) { if (has_next) { PG8_LOADG(nxt, nv); } }
#pragma unroll 1
        for (int t = 0; t < nt; t += 2) {
            const bool last = (t == nt - 2);
            const char* a1 = cA + (size_t)(t + 1) * kstep;
            const char* a2 = last ? nA : cA + (size_t)(t + 2) * kstep; const char* b2 = last ? nB : cB + (size_t)(t + 2) * kstep;
            const char* a3 = a2 + kstep; const char* b3 = b2 + kstep;
            PG8_LDB(B0, 0, 0); PG8_LDB(B1, 0, 1); PG8_SCHED; PG8_LDA(At, 0, 0); PG8_STAGE_A(PG8_SA(1, 1), 1, a1, false);
            PG8_WAIT_V(8); PG8_WAIT_L(0); PG8_BAR; PG8_MMA(0, 0, At, B0); PG8_MMA(0, 1, At, B1); PG8_BAR; PG8_SCHED;
            PG8_LDA(At, 0, 1); PG8_STAGE(PG8_SB(0, 0), b2, voffB); PG8_STAGE(PG8_SB(0, 1), b2 + hstepB, voffB); PG8_STAGE_A(PG8_SA(0, 0), 0, a2, last);
            PG8_WAIT_V(8); PG8_WAIT_L(0); PG8_BAR; PG8_MMA(1, 0, At, B0); PG8_MMA(1, 1, At, B1); PG8_BAR; PG8_SCHED;
            PG8_LDB(B0, 1, 0); PG8_LDB(B1, 1, 1); PG8_SCHED; PG8_LDA(At, 1, 0); PG8_STAGE_A(PG8_SA(0, 1), 1, a2, last);
            PG8_WAIT_V(8); PG8_WAIT_L(0); PG8_BAR; PG8_MMA(0, 0, At, B0); PG8_MMA(0, 1, At, B1); PG8_BAR; PG8_SCHED;
            PG8_LDA(At, 1, 1); PG8_STAGE(PG8_SB(1, 0), b3, voffB); PG8_STAGE(PG8_SB(1, 1), b3 + hstepB, voffB); PG8_STAGE_A(PG8_SA(1, 0), 0, a3, last);
            PG8_WAIT_V(8); PG8_WAIT_L(0); PG8_BAR; PG8_MMA(1, 0, At, B0); PG8_MMA(1, 1, At, B1); PG8_BAR; PG8_SCHED;
        }
        if constexpr (ALIGN_EPI) { if (wr == 0) PG8_BAR; }
        E(acc, cur, wr, wc, fr, fq);
        if (!has_next) break;
#pragma unroll
        for (int a = 0; a < 2; ++a)
#pragma unroll
            for (int b = 0; b < 2; ++b)
#pragma unroll
                for (int m = 0; m < 4; ++m)
#pragma unroll
                    for (int n = 0; n < 2; ++n) acc[a][b][m][n] = (f32x4){0.f, 0.f, 0.f, 0.f};
        cur = nxt; cA = nA; cB = nB; ++ui;
#pragma unroll
        for (int h_ = 0; h_ < 2; ++h_) { cv[h_][0] = nv[h_][0]; cv[h_][1] = nv[h_][1]; }
        if constexpr (ALIGN_EPI) { if (wr == 1) PG8_BAR; }
    }
    PG8_WAIT_V(0);
    if constexpr (!ALIGN_EPI) { if (wr == 0) PG8_BAR; }
    PG8_BAR;
#undef PG8_SA
#undef PG8_SB
#undef PG8_STAGE
#undef PG8_STAGE_A
#undef PG8_LOADG
#undef PG8_LDA
#undef PG8_LDB
#undef PG8_MMA
#undef PG8_WAIT_V
#undef PG8_WAIT_L
#undef PG8_BAR
#undef PG8_SCHED
}

typedef const f32x4 (&AccRef)[2][2][4][2];

struct EpiInProj {
    static constexpr bool PERM = true;
    bf16_t* H; const f32x2* rope64; const f32x2* rope32;
    __device__ __forceinline__ void operator()(AccRef acc, const Unit& u, int wr, int wc, int fr, int fq) const {
        const int pn = u.pn;
#pragma unroll
        for (int bj = 0; bj < 2; ++bj) {
            const int c0 = pn * BM + bj * HALF + wc * 32 + 8 * fq;
            int mode; float sc = 1.0f;
            if (pn < 4) { mode = 1; if (pn >= 2) sc = 0.08838834764831845f; }
            else if (pn == 8 || pn == 9) { mode = 2; sc = 0.125f; }
            else if (pn == 10 && bj == 0) { mode = 2; }
            else mode = 0;
#pragma unroll
            for (int ai = 0; ai < 2; ++ai)
#pragma unroll
                for (int m = 0; m < 4; ++m) {
                    const int row = u.pm * BM + ai * HALF + wr * 64 + m * 16 + fr;
                    f32x4 v0 = acc[ai][bj][m][0], v1 = acc[ai][bj][m][1];
                    if (mode != 0) {
                        const int s = row & (SEQ - 1);
                        const f32x4* tp = (mode == 1) ? (const f32x4*)(rope64 + (size_t)s * 64 + ((c0 & 127) >> 1)) : (const f32x4*)(rope32 + (size_t)s * 32 + ((c0 & 63) >> 1));
                        const f32x4 t0 = tp[0], t1 = tp[1];
                        f32x4 o0, o1;
                        o0[0] = v0[0] * t0[0] - v0[1] * t0[1]; o0[1] = v0[0] * t0[1] + v0[1] * t0[0];
                        o0[2] = v0[2] * t0[2] - v0[3] * t0[3]; o0[3] = v0[2] * t0[3] + v0[3] * t0[2];
                        o1[0] = v1[0] * t1[0] - v1[1] * t1[1]; o1[1] = v1[0] * t1[1] + v1[1] * t1[0];
                        o1[2] = v1[2] * t1[2] - v1[3] * t1[3]; o1[3] = v1[2] * t1[3] + v1[3] * t1[2];
                        v0 = o0 * sc; v1 = o1 * sc;
                    }
                    u32x4 w; w.x = cvt_pk_bf16(v0[0], v0[1]); w.y = cvt_pk_bf16(v0[2], v0[3]); w.z = cvt_pk_bf16(v1[0], v1[1]); w.w = cvt_pk_bf16(v1[2], v1[3]);
                    *(u32x4*)(H + (size_t)row * IN_EVEN + c0) = w;
                }
        }
    }
};
struct EpiResid {
    static constexpr bool PERM = true;
    const bf16_t* XB; bf16_t* Y;
    __device__ __forceinline__ void operator()(AccRef acc, const Unit& u, int wr, int wc, int fr, int fq) const {
#pragma unroll
        for (int ai = 0; ai < 2; ++ai)
#pragma unroll
            for (int m = 0; m < 4; ++m) {
                const size_t row = (size_t)(u.pm * BM + ai * HALF + wr * 64 + m * 16 + fr);
#pragma unroll
                for (int bj = 0; bj < 2; ++bj) {
                    const int c0 = u.pn * BM + bj * HALF + wc * 32 + 8 * fq;
                    const u32x4 xb = *(const u32x4*)(XB + row * DM + c0);
                    const f32x4 v0 = acc[ai][bj][m][0], v1 = acc[ai][bj][m][1];
                    u32x4 w;
                    w.x = cvt_pk_bf16(v0[0] + ALPHA * bf_lo(xb.x), v0[1] + ALPHA * bf_hi(xb.x)); w.y = cvt_pk_bf16(v0[2] + ALPHA * bf_lo(xb.y), v0[3] + ALPHA * bf_hi(xb.y));
                    w.z = cvt_pk_bf16(v1[0] + ALPHA * bf_lo(xb.z), v1[1] + ALPHA * bf_hi(xb.z)); w.w = cvt_pk_bf16(v1[2] + ALPHA * bf_lo(xb.w), v1[3] + ALPHA * bf_hi(xb.w));
                    *(u32x4*)(Y + row * DM + c0) = w;
                }
            }
    }
};
struct EpiGateUp {
    static constexpr bool PERM = true;
    bf16_t* HID;
    __device__ __forceinline__ void operator()(AccRef acc, const Unit& u, int wr, int wc, int fr, int fq) const {
#pragma unroll
        for (int ai = 0; ai < 2; ++ai)
#pragma unroll
            for (int m = 0; m < 4; ++m) {
                const size_t row = (size_t)(u.pm * BM + ai * HALF + wr * 64 + m * 16 + fr);
#pragma unroll
                for (int bj = 0; bj < 2; ++bj) {
                    const int c0 = u.pn * BM + bj * HALF + wc * 32 + 8 * fq;
                    const f32x4 v0 = acc[ai][bj][m][0], v1 = acc[ai][bj][m][1];
                    u32x2 w; w.x = cvt_pk_bf16(silu_f(v0[0]) * v0[1], silu_f(v0[2]) * v0[3]); w.y = cvt_pk_bf16(silu_f(v1[0]) * v1[1], silu_f(v1[2]) * v1[3]);
                    *(u32x2*)(HID + row * EH + (c0 >> 1)) = w;
                }
            }
    }
};
struct EpiDown {
    static constexpr bool PERM = true;
    bf16_t* YS; const float* gate;
    __device__ __forceinline__ void operator()(AccRef acc, const Unit& u, int wr, int wc, int fr, int fq) const {
#pragma unroll
        for (int ai = 0; ai < 2; ++ai)
#pragma unroll
            for (int m = 0; m < 4; ++m) {
                const size_t row = (size_t)(u.pm * BM + ai * HALF + wr * 64 + m * 16 + fr);
                const float g = gate[row];
#pragma unroll
                for (int bj = 0; bj < 2; ++bj) {
                    const int c0 = u.pn * BM + bj * HALF + wc * 32 + 8 * fq;
                    const f32x4 v0 = acc[ai][bj][m][0] * g, v1 = acc[ai][bj][m][1] * g;
                    u32x4 w; w.x = cvt_pk_bf16(v0[0], v0[1]); w.y = cvt_pk_bf16(v0[2], v0[3]); w.z = cvt_pk_bf16(v1[0], v1[1]); w.w = cvt_pk_bf16(v1[2], v1[3]);
                    *(u32x4*)(YS + row * DM + c0) = w;
                }
            }
    }
};
struct EpiWpp {
    static constexpr bool PERM = true;
    bf16_t* WPP;
    __device__ __forceinline__ void operator()(AccRef acc, const Unit& u, int wr, int wc, int fr, int fq) const {
        const int o = u.tag >> 2, g = u.tag & 3;
        bf16_t* base = WPP + (size_t)o * 1024 * 2048 + u.pn * 1024 + g * 256;
#pragma unroll
        for (int ai = 0; ai < 2; ++ai)
#pragma unroll
            for (int m = 0; m < 4; ++m) {
                const size_t row = (size_t)(u.pm * BM + ai * HALF + wr * 64 + m * 16 + fr);
#pragma unroll
                for (int bj = 0; bj < 2; ++bj) {
                    const int c0 = bj * HALF + wc * 32 + 8 * fq;
                    const f32x4 v0 = acc[ai][bj][m][0], v1 = acc[ai][bj][m][1];
                    u32x4 w; w.x = cvt_pk_bf16(v0[0], v0[1]); w.y = cvt_pk_bf16(v0[2], v0[3]); w.z = cvt_pk_bf16(v1[0], v1[1]); w.w = cvt_pk_bf16(v1[2], v1[3]);
                    *(u32x4*)(base + row * 2048 + c0) = w;
                }
            }
    }
};
struct WppOrder {
    static constexpr bool GATHER = false;
    const char* WFO; const char* CH; int G, c;
    __device__ __forceinline__ bool next(int i, Unit& u) const {
        const int L = i * G + c; if (L >= 64) return false;
        const int o = L >> 5, g = (L >> 3) & 3, pm = (L >> 1) & 3, pn = L & 1;
        u.pm = pm; u.pn = pn; u.tag = (o << 2) | g; u.pad = 0; u.gi = nullptr;
        u.a = WFO + (size_t)o * 1024 * 1024 * 2 + (size_t)pm * BM * 1024 * 2 + (size_t)g * 256 * 2;
        u.b = CH + (size_t)pn * BM * 256 * 2; return true;
    }
};
}

__device__ __forceinline__ bf16x8 frag_row(ldsp base, int rs, int r0, int k0, int lane) {
    return *(const LAS bf16x8*)(base + (r0 + (lane & 15)) * rs + (k0 + 8 * (lane >> 4)) * 2);
}
__device__ __forceinline__ unsigned tr_lane_base(unsigned base_u32, int rs, int lane) {
    const int g = lane >> 4, q = (lane & 15) >> 2, p = lane & 3;
    return base_u32 + (unsigned)((8 * g + q) * rs + 8 * p);
}
__device__ __forceinline__ bf16x8 frag_tr(unsigned lane_base, const int rs, const int k0, const int n0, int  ) {
    bf16x4 r0, r1;
    asm volatile("ds_read_b64_tr_b16 %0, %2 offset:%3\n\tds_read_b64_tr_b16 %1, %2 offset:%4\n\ts_waitcnt lgkmcnt(0)" : "=&v"(r0), "=&v"(r1) : "v"(lane_base), "i"(k0 * rs + n0 * 2), "i"(k0 * rs + n0 * 2 + 4 * rs) : "memory");
    bf16x8 r; r[0] = r0[0]; r[1] = r0[1]; r[2] = r0[2]; r[3] = r0[3]; r[4] = r1[0]; r[5] = r1[1]; r[6] = r1[2]; r[7] = r1[3];
    return r;
}
__device__ __forceinline__ void frag_tr4(bf16x8 (&out)[4], unsigned lane_base, const int rs, const int k0, const int n0) {
    bf16x4 a0, a1, b0, b1, c0, c1, d0, d1;
    asm volatile("ds_read_b64_tr_b16 %0, %8 offset:%9\n\tds_read_b64_tr_b16 %1, %8 offset:%10\n\t"
                 "ds_read_b64_tr_b16 %2, %8 offset:%11\n\tds_read_b64_tr_b16 %3, %8 offset:%12\n\t"
                 "ds_read_b64_tr_b16 %4, %8 offset:%13\n\tds_read_b64_tr_b16 %5, %8 offset:%14\n\t"
                 "ds_read_b64_tr_b16 %6, %8 offset:%15\n\tds_read_b64_tr_b16 %7, %8 offset:%16\n\t"
                 "s_waitcnt lgkmcnt(0)"
                 : "=&v"(a0), "=&v"(a1), "=&v"(b0), "=&v"(b1), "=&v"(c0), "=&v"(c1), "=&v"(d0), "=&v"(d1)
                 : "v"(lane_base), "i"(k0 * rs + n0 * 2), "i"(k0 * rs + n0 * 2 + 4 * rs), "i"(k0 * rs + n0 * 2 + 32), "i"(k0 * rs + n0 * 2 + 32 + 4 * rs),
                   "i"(k0 * rs + n0 * 2 + 64), "i"(k0 * rs + n0 * 2 + 64 + 4 * rs), "i"(k0 * rs + n0 * 2 + 96), "i"(k0 * rs + n0 * 2 + 96 + 4 * rs)
                 : "memory");
    out[0] = (bf16x8){a0[0], a0[1], a0[2], a0[3], a1[0], a1[1], a1[2], a1[3]};
    out[1] = (bf16x8){b0[0], b0[1], b0[2], b0[3], b1[0], b1[1], b1[2], b1[3]};
    out[2] = (bf16x8){c0[0], c0[1], c0[2], c0[3], c1[0], c1[1], c1[2], c1[3]};
    out[3] = (bf16x8){d0[0], d0[1], d0[2], d0[3], d1[0], d1[1], d1[2], d1[3]};
}
#define MFMA16(a, b, c) __builtin_amdgcn_mfma_f32_16x16x32_bf16((a), (b), (c), 0, 0, 0)

template <int ROWS, int CPR>
__device__ __forceinline__ void stage_tile(ldsp dst, int rs, const unsigned char* src, size_t gs, int tid) {
    constexpr int NIT = ROWS * CPR / 512;
    static_assert(ROWS * CPR % 512 == 0, "tile chunks must be a multiple of the workgroup size");
    u32x4 v[NIT];
#pragma unroll
    for (int it = 0; it < NIT; ++it) { const int c = tid + it * 512, r = c / CPR, ch = c % CPR; v[it] = *(const u32x4*)(src + (size_t)r * gs + ch * 16); }
#pragma unroll
    for (int it = 0; it < NIT; ++it) { const int c = tid + it * 512, r = c / CPR, ch = c % CPR; *(LAS u32x4*)(dst + r * rs + ch * 16) = v[it]; }
}

struct Args { const float* in[18]; float* out; unsigned char* ws; int ph_lo, ph_hi; };
enum { I_X = 0, I_WIN, I_DECAY, I_GN, I_SINK, I_WOUT, I_WFO, I_LN1G, I_LN1B, I_LN2G, I_LN2B, I_RCW, I_RCB, I_RFW, I_RFB, I_EWG, I_EWU, I_EWD };

struct Frame { ldsp lds; unsigned lds_u32; int tid, lane, wave, vcu, G; unsigned char* ws; };

template <int MAP>
__device__ __forceinline__ void p0_transpose_item(const float* W, int K, int N, bf16_t* WT, LAS float* scr, int item, int lane) {
    const int nblk = N / 32, kb = item / nblk, nb = item % nblk, k0 = 64 * kb, n0 = 32 * nb;
#pragma unroll 8
    for (int i = 0; i < 32; ++i) { const int kk = 2 * i + (lane >> 5); scr[kk * 33 + (lane & 31)] = W[(size_t)(k0 + kk) * N + n0 + (lane & 31)]; }
    asm volatile("s_waitcnt lgkmcnt(0)" ::: "memory");
    const int c = lane & 7;
#pragma unroll
    for (int j = 0; j < 4; ++j) { const int n = (lane >> 3) + 8 * j; const LAS float* s = scr + (8 * c) * 33 + n;
        u32x4 o; o.x = pk2(s[0 * 33], s[1 * 33]); o.y = pk2(s[2 * 33], s[3 * 33]); o.z = pk2(s[4 * 33], s[5 * 33]); o.w = pk2(s[6 * 33], s[7 * 33]);
        int nn = n0 + n;
        if (MAP == 1) {
            if (nn < 1024) { const int hd = nn >> 7, jj = nn & 127; nn = hd * 128 + 2 * (jj & 63) + (jj >> 6); }
            else if (nn >= C_QB && nn < C_VB) { const int mm = nn - C_QB, hd = mm >> 6, jj = mm & 63; nn = C_QB + hd * 64 + 2 * (jj & 31) + (jj >> 5); }
        } else if (MAP == 2) nn = 2 * nn; else if (MAP == 3) nn = 2 * nn + 1;
        *(u32x4*)(WT + (size_t)nn * K + k0 + 8 * c) = o; }
    asm volatile("s_waitcnt lgkmcnt(0)" ::: "memory");
}
__device__ __forceinline__ void p0a_prologue(const Frame& F, const Args& a) {
    LAS float* scr = (LAS float*)(F.lds + F.wave * 16384);
    const int gw = F.vcu * 8 + F.wave, NGW = F.G * 8;
    unsigned char* ws = F.ws;
    constexpr int I_IN = 16 * 88, I_SQ = 16 * 32, I_GU = 16 * 16, I_DN = 8 * 32;
    constexpr int N0 = 2 * I_IN, N1 = N0 + 2 * I_SQ, N2 = N1 + 2 * I_SQ, N3 = N2 + 128 * I_GU, N4 = N3 + 128 * I_GU, N5 = N4 + 128 * I_DN;
    for (int it = gw; it < N5; it += NGW) {
        if (it < N0) { const int e = it / I_IN, r = it % I_IN; p0_transpose_item<1>(a.in[I_WIN] + (size_t)e * 1024 * IN_EVEN, 1024, IN_EVEN, (bf16_t*)(ws + WS_WIN) + (size_t)e * IN_EVEN * 1024, scr, r, F.lane); }
        else if (it < N1) { const int q = it - N0, e = q / I_SQ, r = q % I_SQ; p0_transpose_item<0>(a.in[I_WOUT] + (size_t)e * 1024 * 1024, 1024, 1024, (bf16_t*)(ws + WS_WOUT) + (size_t)e * 1024 * 1024, scr, r, F.lane); }
        else if (it < N2) { const int q = it - N1, e = q / I_SQ, r = q % I_SQ; p0_transpose_item<0>(a.in[I_WFO] + (size_t)e * 1024 * 1024, 1024, 1024, (bf16_t*)(ws + WS_WFO) + (size_t)e * 1024 * 1024, scr, r, F.lane); }
        else if (it < N3) { const int q = it - N2, e = q / I_GU, r = q % I_GU; p0_transpose_item<2>(a.in[I_EWG] + (size_t)e * 1024 * EH, 1024, EH, (bf16_t*)(ws + WS_WGU) + (size_t)e * 1024 * 1024, scr, r, F.lane); }
        else if (it < N4) { const int q = it - N3, e = q / I_GU, r = q % I_GU; p0_transpose_item<3>(a.in[I_EWU] + (size_t)e * 1024 * EH, 1024, EH, (bf16_t*)(ws + WS_WGU) + (size_t)e * 1024 * 1024, scr, r, F.lane); }
        else { const int q = it - N4, e = q / I_DN, r = q % I_DN; p0_transpose_item<0>(a.in[I_EWD] + (size_t)e * EH * 1024, EH, 1024, (bf16_t*)(ws + WS_WD) + (size_t)e * 1024 * EH, scr, r, F.lane); }
    }
    const int gt = F.vcu * 512 + F.tid, NGT = F.G * 512;
    {
        f32x2* r64 = (f32x2*)(ws + WS_ROPE64); f32x2* r32 = (f32x2*)(ws + WS_ROPE32);
        for (int idx = gt; idx < SEQ * 96; idx += NGT) {
            const int s = idx / 96, i = idx % 96; const bool big = i < 64; const int ii = big ? i : i - 64;
            const double base = big ? 0.8659643233600653 : 0.7498942093324558;
            double inv = 1.0; for (int k = 0; k < ii; ++k) inv *= base;
            const double turns = (double)s * inv * 0.15915494309189535;
            const double fr = turns - __builtin_rint(turns);
            double sn, cs; sincos_turn(fr, sn, cs);
            const f32x2 v = {(float)cs, (float)sn};
            if (big) r64[(size_t)s * 64 + ii] = v; else r32[(size_t)s * 32 + ii] = v;
        }
    }
    {
        bf16_t* t1 = (bf16_t*)(ws + WS_FFT1);
        for (int idx = gt; idx < 64 * 128 * 64; idx += NGT) {
            const int n2 = idx >> 13, row = (idx >> 6) & 127, n1 = idx & 63, k1 = row & 63;
            double sn, cs; sincos_frac(k1 * (64 * n1 + n2), 4096, sn, cs);
            t1[idx] = (bf16_t)f2bf((float)((row < 64 ? cs : -sn) * (1.0 / 64.0)));
        }
        bf16_t* t2 = (bf16_t*)(ws + WS_FFT2);
        for (int idx = gt; idx < 128 * 128; idx += NGT) {
            const int r = idx >> 7, c = idx & 127, k2 = r & 63, n2 = c & 63, ri = r >> 6, rj = c >> 6;
            double sn, cs; sincos_frac(k2 * n2, 64, sn, cs);
            const double v = (ri == rj) ? cs : (ri == 0 ? sn : -sn);
            t2[idx] = (bf16_t)f2bf((float)v);
        }
        bf16_t* t3 = (bf16_t*)(ws + WS_CHDFT);
        for (int idx = gt; idx < 512 * 256; idx += NGT) {
            const int r = idx >> 8, cp = idx & 255, c = r & 255, ri = r >> 8;
            double sn, cs; sincos_frac(c * cp, 256, sn, cs);
            t3[idx] = (bf16_t)f2bf((float)((ri == 0 ? cs : sn) * (1.0 / 16.0)));
        }
        bf16_t* wr = (bf16_t*)(ws + WS_WRT);
        for (int idx = gt; idx < DEPTH * 48 * 1024; idx += NGT) {
            const int L = idx / (48 * 1024), o = (idx / 1024) % 48, k = idx & 1023;
            const float v = (o < 4) ? a.in[I_RCW][((size_t)L * 1024 + k) * 4 + o] : (o < 36 ? a.in[I_RFW][((size_t)L * 1024 + k) * 32 + (o - 4)] : 0.f);
            wr[idx] = (bf16_t)f2bf(v * a.in[I_LN1G][L * 1024 + k]);
        }
    }
    {
        float* sgbw = (float*)(ws + WS_WRT + 512 * 1024);
        for (int it = gw; it < DEPTH * 48; it += NGW) {
            const int L = it / 48, o = it % 48; float sg = 0.f, bw = 0.f;
            if (o < 36) {
                for (int j = 0; j < 16; ++j) { const int k = F.lane + 64 * j;
                    const float wv = (o < 4) ? a.in[I_RCW][((size_t)L * 1024 + k) * 4 + o] : a.in[I_RFW][((size_t)L * 1024 + k) * 32 + (o - 4)];
                    sg += bf_lo(f2bf(wv * a.in[I_LN1G][L * 1024 + k])); bw += wv * a.in[I_LN1B][L * 1024 + k]; }
                sg = wave_sum(sg); bw = wave_sum(bw) + (o < 4 ? a.in[I_RCB][L * 4 + o] : a.in[I_RFB][L * 32 + o - 4]);
            }
            if (F.lane == 0) { sgbw[2 * it] = sg; sgbw[2 * it + 1] = bw; }
        }
    }
    {
        const f32x4* x4 = (const f32x4*)a.in[I_X]; u32x2* xb = (u32x2*)(ws + WS_XB);
        for (size_t idx = gt; idx < (size_t)NT * DM / 4; idx += NGT) { const f32x4 v = x4[idx]; u32x2 o; o.x = pk2(v[0], v[1]); o.y = pk2(v[2], v[3]); xb[idx] = o; }
    }
}

__device__ __forceinline__ float log2_sigmoid(float z) { return -__log2f(1.0f + __expf(-z)); }
constexpr int RS128 = 272;
__device__ __forceinline__ void a2_ret_states(const Frame& F, const float* decay  ) {
    const bf16_t* H = (const bf16_t*)(F.ws + WS_SCR + SC_H);
    float* KV = (float*)(F.ws + WS_SCR + SC_KV);
    const ldsp Vt = F.lds, Kf = F.lds + 128 * RS128, Kb = F.lds + 2 * 128 * RS128;
    const unsigned uV = tr_lane_base(F.lds_u32, RS128, F.lane), uKf = uV + 128 * RS128, uKb = uV + 2 * 128 * RS128;
    const int lane = F.lane, w = F.wave;
    for (int u = F.vcu; u < 1024; u += F.G) {
        const int b = u >> 7, hh = (u >> 5) & 3, n = u & 31;
        const size_t t0 = (size_t)b * SEQ + n * 128;
        const float lgf = log2_sigmoid(decay[hh]), lgb = log2_sigmoid(decay[4 + hh]);
        __syncthreads();
        {
            u32x4 vv[4], kk[4];
#pragma unroll
            for (int it = 0; it < 4; ++it) { const int c = F.tid + it * 512, r = c >> 4, ch = c & 15;
                vv[it] = *(const u32x4*)(H + (t0 + r) * IN_EVEN + C_VA + hh * 128 + ch * 8); kk[it] = *(const u32x4*)(H + (t0 + r) * IN_EVEN + C_KA + hh * 128 + ch * 8); }
#pragma unroll
            for (int it = 0; it < 4; ++it) { const int c = F.tid + it * 512, r = c >> 4, ch = c & 15;
                *(LAS u32x4*)(Vt + r * RS128 + ch * 16) = vv[it];
                const float zf = exp2f(lgf * (float)(127 - r)), zb = exp2f(lgb * (float)r);
                const u32x4 k4 = kk[it]; u32x4 of, ob;
                of.x = pk2(bf_lo(k4.x) * zf, bf_hi(k4.x) * zf); of.y = pk2(bf_lo(k4.y) * zf, bf_hi(k4.y) * zf); of.z = pk2(bf_lo(k4.z) * zf, bf_hi(k4.z) * zf); of.w = pk2(bf_lo(k4.w) * zf, bf_hi(k4.w) * zf);
                ob.x = pk2(bf_lo(k4.x) * zb, bf_hi(k4.x) * zb); ob.y = pk2(bf_lo(k4.y) * zb, bf_hi(k4.y) * zb); ob.z = pk2(bf_lo(k4.z) * zb, bf_hi(k4.z) * zb); ob.w = pk2(bf_lo(k4.w) * zb, bf_hi(k4.w) * zb);
                *(LAS u32x4*)(Kf + r * RS128 + ch * 16) = of;
                *(LAS u32x4*)(Kb + r * RS128 + ch * 16) = ob; }
        }
        __syncthreads();
        f32x4 af[8], ab[8];
#pragma unroll
        for (int i = 0; i < 8; ++i) { af[i] = (f32x4){0.f, 0.f, 0.f, 0.f}; ab[i] = (f32x4){0.f, 0.f, 0.f, 0.f}; }
#pragma unroll
        for (int ks = 0; ks < 4; ++ks) {
            const bf16x8 a = frag_tr(uV + 32 * w, RS128, 32 * ks, 0, lane);
#pragma unroll
            for (int h4 = 0; h4 < 2; ++h4) {
                bf16x8 kf[4], kb[4];
                frag_tr4(kf, uKf, RS128, 32 * ks, 64 * h4); frag_tr4(kb, uKb, RS128, 32 * ks, 64 * h4);
#pragma unroll
                for (int q = 0; q < 4; ++q) { af[4 * h4 + q] = MFMA16(kf[q], a, af[4 * h4 + q]); ab[4 * h4 + q] = MFMA16(kb[q], a, ab[4 * h4 + q]); }
            }
        }
        float* of = KV + (size_t)u * 2 * 16384 + (16 * w + (lane & 15)) * 128 + 4 * (lane >> 4); float* ob = of + 16384;
#pragma unroll
        for (int nt = 0; nt < 8; ++nt) { *(f32x4*)(of + 16 * nt) = af[nt]; *(f32x4*)(ob + 16 * nt) = ab[nt]; }
    }
}
__device__ __forceinline__ void a3_ret_scan(const Frame& F, const float* decay) {
    const float* KV = (const float*)(F.ws + WS_SCR + SC_KV);
    bf16_t* RT = (bf16_t*)(F.ws + WS_SCR + SC_RT);
    for (int it = F.vcu * 512 + F.tid; it < 32 * 2 * 2048; it += F.G * 512) {
        const int bh = it >> 12, dir = (it >> 11) & 1, e8 = (it & 2047) * 8, hh = bh & 3;
        const float cd = exp2f(128.0f * log2_sigmoid(decay[dir * 4 + hh]));
        f32x4 s0 = {0.f, 0.f, 0.f, 0.f}, s1 = {0.f, 0.f, 0.f, 0.f};
        for (int k = 0; k < 32; ++k) {
            const int n = dir ? 31 - k : k;
            const size_t off = ((size_t)(bh * 32 + n) * 2 + dir) * 16384 + e8;
            u32x4 o; o.x = pk2(s0[0], s0[1]); o.y = pk2(s0[2], s0[3]); o.z = pk2(s1[0], s1[1]); o.w = pk2(s1[2], s1[3]);
            *(u32x4*)(RT + off) = o;
            const f32x4 k0 = *(const f32x4*)(KV + off), k1 = *(const f32x4*)(KV + off + 4);
            s0 = s0 * cd + k0; s1 = s1 * cd + k1;
        }
    }
}
__device__ __forceinline__ void a4_ret_unit(const Frame& F, int u, const float* decay, const float* gn_gain) {
    const bf16_t* H = (const bf16_t*)(F.ws + WS_SCR + SC_H);
    const bf16_t* RT = (const bf16_t*)(F.ws + WS_SCR + SC_RT);
    bf16_t* YC = (bf16_t*)(F.ws + WS_SCR + SC_YCAT);
    const ldsp Qs = F.lds, Ks = F.lds + 128 * RS128, Vs = F.lds + 2 * 128 * RS128, Ps = F.lds + 3 * 128 * RS128;
    const unsigned uVs = tr_lane_base(F.lds_u32 + 2 * 128 * RS128, RS128, F.lane);
    const int lane = F.lane, w = F.wave, g = lane >> 4, cl = lane & 15;
    const int b = u >> 7, hh = (u >> 5) & 3, n = u & 31;
    const size_t t0 = (size_t)b * SEQ + n * 128;
    const float lgf = log2_sigmoid(decay[hh]), lgb = log2_sigmoid(decay[4 + hh]);
    const int il = 16 * w + cl;
    __syncthreads();
    stage_tile<128, 16>(Qs, RS128, (const unsigned char*)(H + t0 * IN_EVEN + C_QA + hh * 128), IN_EVEN * 2, F.tid);
    stage_tile<128, 16>(Ks, RS128, (const unsigned char*)(H + t0 * IN_EVEN + C_KA + hh * 128), IN_EVEN * 2, F.tid);
    stage_tile<128, 16>(Vs, RS128, (const unsigned char*)(H + t0 * IN_EVEN + C_VA + hh * 128), IN_EVEN * 2, F.tid);
    __syncthreads();
    bf16x8 qf[4];
#pragma unroll
    for (int ks = 0; ks < 4; ++ks) qf[ks] = frag_row(Qs, RS128, 16 * w, 32 * ks, lane);
    f32x4 acc[8];
#pragma unroll
    for (int i = 0; i < 8; ++i) acc[i] = (f32x4){0.f, 0.f, 0.f, 0.f};
#pragma unroll
    for (int ks = 0; ks < 4; ++ks)
#pragma unroll
        for (int nt = 0; nt < 8; ++nt) acc[nt] = MFMA16(frag_row(Ks, RS128, 16 * nt, 32 * ks, lane), qf[ks], acc[nt]);
#pragma unroll
    for (int nt = 0; nt < 8; ++nt) {
        float pv[4];
#pragma unroll
        for (int i = 0; i < 4; ++i) { const int d = il - (16 * nt + 4 * g + i); pv[i] = acc[nt][i] * (d >= 0 ? exp2f(lgf * (float)d) : exp2f(lgb * (float)(-d))); }
        u32x2 pw; pw.x = pk2(pv[0], pv[1]); pw.y = pk2(pv[2], pv[3]);
        *(LAS u32x2*)(Ps + il * RS128 + (16 * nt + 4 * g) * 2) = pw;
    }
    f32x4 y[8];
#pragma unroll
    for (int i = 0; i < 8; ++i) y[i] = (f32x4){0.f, 0.f, 0.f, 0.f};
#pragma unroll
    for (int ks = 0; ks < 4; ++ks) {
        const bf16x8 pf = frag_row(Ps, RS128, 16 * w, 32 * ks, lane);
#pragma unroll
        for (int h4 = 0; h4 < 2; ++h4) { bf16x8 vf[4]; frag_tr4(vf, uVs, RS128, 32 * ks, 64 * h4);
#pragma unroll
            for (int q = 0; q < 4; ++q) y[4 * h4 + q] = MFMA16(vf[q], pf, y[4 * h4 + q]); }
    }
#pragma unroll 1
    for (int dir = 0; dir < 2; ++dir) {
        const bf16_t* Rg = RT + ((size_t)u * 2 + dir) * 16384 + cl * 128 + 8 * g;
#pragma unroll
        for (int i = 0; i < 8; ++i) acc[i] = (f32x4){0.f, 0.f, 0.f, 0.f};
#pragma unroll 1
        for (int kp = 0; kp < 2; ++kp) {
            bf16x8 rf[2][8];
#pragma unroll
            for (int k2 = 0; k2 < 2; ++k2)
#pragma unroll
                for (int nt = 0; nt < 8; ++nt) rf[k2][nt] = *(const bf16x8*)(Rg + 16 * nt * 128 + 64 * kp + 32 * k2);
#pragma unroll
            for (int k2 = 0; k2 < 2; ++k2) {
                const bf16x8 qk = frag_row(Qs, RS128, 16 * w, 64 * kp + 32 * k2, lane);
#pragma unroll
                for (int nt = 0; nt < 8; ++nt) acc[nt] = MFMA16(rf[k2][nt], qk, acc[nt]);
            }
        }
        const float xi = dir == 0 ? exp2f(lgf * (float)(il + 1)) : exp2f(lgb * (float)(128 - il));
#pragma unroll
        for (int nt = 0; nt < 8; ++nt) y[nt] += acc[nt] * xi;
    }
    float sm = 0.f;
#pragma unroll
    for (int nt = 0; nt < 8; ++nt) sm += (y[nt][0] + y[nt][1]) + (y[nt][2] + y[nt][3]);
    sm += __shfl_xor(sm, 16); sm += __shfl_xor(sm, 32);
    const float mu = sm * (1.0f / 128.0f);
    float qq = 0.f;
#pragma unroll
    for (int nt = 0; nt < 8; ++nt) { const f32x4 d = y[nt] - mu; qq += (d[0] * d[0] + d[1] * d[1]) + (d[2] * d[2] + d[3] * d[3]); }
    qq += __shfl_xor(qq, 16); qq += __shfl_xor(qq, 32);
    const float rstd = 1.0f / sqrtf(qq * (1.0f / 128.0f) + GN_EPS);
    const size_t t = t0 + il;
#pragma unroll
    for (int nt = 0; nt < 8; ++nt) {
        const int dv = 16 * nt + 4 * g;
        const u32x2 ga = *(const u32x2*)(H + t * IN_EVEN + C_GA + hh * 128 + dv);
        const f32x4 gg = *(const f32x4*)(gn_gain + hh * 128 + dv);
        const f32x4 o = (y[nt] - mu) * rstd * gg;
        u32x2 ow; ow.x = pk2(o[0] * silu_f(bf_lo(ga.x)), o[1] * silu_f(bf_hi(ga.x))); ow.y = pk2(o[2] * silu_f(bf_lo(ga.y)), o[3] * silu_f(bf_hi(ga.y)));
        *(u32x2*)(YC + t * DM + hh * 128 + dv) = ow;
    }
}
constexpr int RS64 = 144;
__device__ __forceinline__ void a4_win_unit(const Frame& F, int u, const float* sink) {
    const bf16_t* H = (const bf16_t*)(F.ws + WS_SCR + SC_H);
    bf16_t* YC = (bf16_t*)(F.ws + WS_SCR + SC_YCAT);
    const ldsp Ks = F.lds, Vs = F.lds + 384 * RS64, Pw = F.lds + 2 * 384 * RS64 + F.wave * (16 * RS128);
    const unsigned uVs = tr_lane_base(F.lds_u32 + 384 * RS64, RS64, F.lane);
    const int lane = F.lane, w = F.wave, g = lane >> 4, cl = lane & 15;
    const int b = u >> 6, kvh = (u >> 5) & 1, n = u & 31;
    const size_t tb = (size_t)b * SEQ;
    __syncthreads();
    {
        u32x4 kk[6], vv[6];
#pragma unroll
        for (int it = 0; it < 6; ++it) { const int c = F.tid + it * 512, r = c >> 3, ch = c & 7, kp = n * 128 - 128 + r;
            kk[it] = (u32x4){0u, 0u, 0u, 0u}; vv[it] = (u32x4){0u, 0u, 0u, 0u};
            if (kp >= 0 && kp < SEQ) { kk[it] = *(const u32x4*)(H + (tb + kp) * IN_EVEN + C_KB + kvh * 64 + ch * 8); vv[it] = *(const u32x4*)(H + (tb + kp) * IN_EVEN + C_VB + kvh * 64 + ch * 8); } }
#pragma unroll
        for (int it = 0; it < 6; ++it) { const int c = F.tid + it * 512, r = c >> 3, ch = c & 7;
            *(LAS u32x4*)(Ks + r * RS64 + ch * 16) = kk[it]; *(LAS u32x4*)(Vs + r * RS64 + ch * 16) = vv[it]; }
    }
    __syncthreads();
#pragma unroll 1
    for (int gq = 0; gq < 4; ++gq) {
        const int qh = kvh * 4 + gq;
        const float sk = sink[qh];
        const size_t tq = tb + n * 128 + 16 * w;
        bf16x8 qa[2];
#pragma unroll
        for (int ks = 0; ks < 2; ++ks) qa[ks] = *(const bf16x8*)(H + (tq + cl) * IN_EVEN + C_QB + qh * 64 + 32 * ks + 8 * g);
        const int dl0 = 4 * g - (16 * w + cl), kp0 = n * 128 - 128 + 4 * g;
        float mx = sk;
#pragma unroll 1
        for (int kb = 0; kb < 3; ++kb) {
            f32x4 s[8];
#pragma unroll
            for (int i = 0; i < 8; ++i) s[i] = (f32x4){0.f, 0.f, 0.f, 0.f};
            const ldsp Kb_ = Ks + kb * 128 * RS64;
#pragma unroll
            for (int ks = 0; ks < 2; ++ks)
#pragma unroll
                for (int nt = 0; nt < 8; ++nt) s[nt] = MFMA16(frag_row(Kb_, RS64, 16 * nt, 32 * ks, lane), qa[ks], s[nt]);
#pragma unroll
            for (int nt = 0; nt < 8; ++nt) {
                const int jb = kb * 128 + 16 * nt;
#pragma unroll
                for (int i = 0; i < 4; ++i) { const bool ok = ((unsigned)(jb + dl0 + i) <= 256u) && ((unsigned)(jb + kp0 + i) < (unsigned)SEQ); mx = fmaxf(mx, ok ? s[nt][i] : -1e30f); }
            }
        }
        mx = fmaxf(mx, __shfl_xor(mx, 16)); mx = fmaxf(mx, __shfl_xor(mx, 32));
        float sum = 0.f;
        f32x4 o[4];
#pragma unroll
        for (int i = 0; i < 4; ++i) o[i] = (f32x4){0.f, 0.f, 0.f, 0.f};
#pragma unroll 1
        for (int kb = 0; kb < 3; ++kb) {
            f32x4 s[8];
#pragma unroll
            for (int i = 0; i < 8; ++i) s[i] = (f32x4){0.f, 0.f, 0.f, 0.f};
            const ldsp Kb_ = Ks + kb * 128 * RS64;
#pragma unroll
            for (int ks = 0; ks < 2; ++ks)
#pragma unroll
                for (int nt = 0; nt < 8; ++nt) s[nt] = MFMA16(frag_row(Kb_, RS64, 16 * nt, 32 * ks, lane), qa[ks], s[nt]);
#pragma unroll
            for (int nt = 0; nt < 8; ++nt) {
                const int jb = kb * 128 + 16 * nt; float pv[4];
#pragma unroll
                for (int i = 0; i < 4; ++i) { const bool ok = ((unsigned)(jb + dl0 + i) <= 256u) && ((unsigned)(jb + kp0 + i) < (unsigned)SEQ);
                    pv[i] = ok ? __expf(s[nt][i] - mx) : 0.f; sum += pv[i]; }
                u32x2 pw; pw.x = pk2(pv[0], pv[1]); pw.y = pk2(pv[2], pv[3]);
                *(LAS u32x2*)(Pw + cl * RS128 + (16 * nt + 4 * g) * 2) = pw;
            }
            const unsigned uVb = uVs + (unsigned)(kb * 128 * RS64);
#pragma unroll
            for (int ks = 0; ks < 4; ++ks) {
                const bf16x8 pf = frag_row(Pw, RS128, 0, 32 * ks, lane);
                bf16x8 vf[4]; frag_tr4(vf, uVb, RS64, 32 * ks, 0);
#pragma unroll
                for (int nt = 0; nt < 4; ++nt) o[nt] = MFMA16(vf[nt], pf, o[nt]);
            }
        }
        sum += __shfl_xor(sum, 16); sum += __shfl_xor(sum, 32);
        const float inv = 1.0f / (sum + __expf(sk - mx));
#pragma unroll
        for (int nt = 0; nt < 4; ++nt) { u32x2 ow; ow.x = pk2(o[nt][0] * inv, o[nt][1] * inv); ow.y = pk2(o[nt][2] * inv, o[nt][3] * inv);
            *(u32x2*)(YC + (tq + cl) * DM + 512 + qh * 64 + 16 * nt + 4 * g) = ow; }
    }
}
constexpr int RS256 = 528;
__device__ __forceinline__ void b1_fft_stage1(const Frame& F) {
    const bf16_t* XB = (const bf16_t*)(F.ws + WS_XB);
    const bf16_t* TAB = (const bf16_t*)(F.ws + WS_FFT1);
    bf16_t* A1 = (bf16_t*)(F.ws + WS_SCR + SC_A1);
    const ldsp Ts = F.lds, Xs = F.lds + 128 * RS64;
    const unsigned uXs = tr_lane_base(F.lds_u32 + 128 * RS64, RS256, F.lane);
    const int lane = F.lane, w = F.wave, g = lane >> 4, cl = lane & 15;
    for (int u = F.vcu; u < 2048; u += F.G) {
        const int b = u >> 8, n2 = (u >> 2) & 63, cb = u & 3;
        __syncthreads();
        stage_tile<128, 8>(Ts, RS64, (const unsigned char*)(TAB + (size_t)n2 * 8192), 128, F.tid);
        stage_tile<64, 32>(Xs, RS256, (const unsigned char*)(XB + ((size_t)b * SEQ + n2) * DM + cb * 256), (size_t)64 * DM * 2, F.tid);
        __syncthreads();
        f32x4 acc[16];
#pragma unroll
        for (int i = 0; i < 16; ++i) acc[i] = (f32x4){0.f, 0.f, 0.f, 0.f};
#pragma unroll
        for (int ks = 0; ks < 2; ++ks) {
            const bf16x8 a = frag_row(Ts, RS64, 16 * w, 32 * ks, lane);
#pragma unroll
            for (int h4 = 0; h4 < 4; ++h4) { bf16x8 xf[4]; frag_tr4(xf, uXs, RS256, 32 * ks, 64 * h4);
#pragma unroll
                for (int q = 0; q < 4; ++q) acc[4 * h4 + q] = MFMA16(xf[q], a, acc[4 * h4 + q]); }
        }
        {
            const int r = 16 * w + cl, ri = r >> 6, k1 = r & 63;
            bf16_t* dst = A1 + ((((size_t)b * 64 + k1) * 2 + ri) * 64 + n2) * DM + cb * 256 + 4 * g;
#pragma unroll
            for (int nt = 0; nt < 16; ++nt) { u32x2 ow; ow.x = pk2(acc[nt][0], acc[nt][1]); ow.y = pk2(acc[nt][2], acc[nt][3]); *(u32x2*)(dst + 16 * nt) = ow; }
        }
    }
}
__device__ __forceinline__ void b2_fft_stage2(const Frame& F) {
    const bf16_t* A1 = (const bf16_t*)(F.ws + WS_SCR + SC_A1);
    const bf16_t* GT = (const bf16_t*)(F.ws + WS_FFT2);
    bf16_t* V2 = (bf16_t*)(F.ws + WS_SCR + SC_V2);
    const ldsp Gs = F.lds, Xs = F.lds + 128 * RS128;
    const unsigned uXs = tr_lane_base(F.lds_u32 + 128 * RS128, RS256, F.lane);
    const int lane = F.lane, w = F.wave, g = lane >> 4, cl = lane & 15;
    for (int u = F.vcu; u < 2048; u += F.G) {
        const int b = u >> 8, k1 = (u >> 2) & 63, cb = u & 3;
        __syncthreads();
        stage_tile<128, 16>(Gs, RS128, (const unsigned char*)GT, 256, F.tid);
        stage_tile<128, 32>(Xs, RS256, (const unsigned char*)(A1 + ((size_t)b * 64 + k1) * 128 * DM + cb * 256), (size_t)DM * 2, F.tid);
        __syncthreads();
        f32x4 acc[16];
#pragma unroll
        for (int i = 0; i < 16; ++i) acc[i] = (f32x4){0.f, 0.f, 0.f, 0.f};
#pragma unroll
        for (int ks = 0; ks < 4; ++ks) {
            const bf16x8 a = frag_row(Gs, RS128, 16 * w, 32 * ks, lane);
#pragma unroll
            for (int h4 = 0; h4 < 4; ++h4) { bf16x8 xf[4]; frag_tr4(xf, uXs, RS256, 32 * ks, 64 * h4);
#pragma unroll
                for (int q = 0; q < 4; ++q) acc[4 * h4 + q] = MFMA16(xf[q], a, acc[4 * h4 + q]); }
        }
        {
            const int r = 16 * w + cl, ri = r >> 6, k2 = r & 63;
            bf16_t* dst = V2 + ((size_t)b * SEQ + k1 + 64 * k2) * 2048 + ri * 1024 + cb * 256 + 4 * g;
#pragma unroll
            for (int nt = 0; nt < 16; ++nt) { u32x2 ow; ow.x = pk2(acc[nt][0], acc[nt][1]); ow.y = pk2(acc[nt][2], acc[nt][3]); *(u32x2*)(dst + 16 * nt) = ow; }
        }
    }
}
constexpr int RSW = 2064;
__device__ __forceinline__ void m1_ln_router(const Frame& F, const Args& a, int L) {
    const bf16_t* YP = (const bf16_t*)(F.ws + WS_SCR + SC_YPRE);
    bf16_t* X1 = (bf16_t*)(F.ws + WS_X1B);
    const bf16_t* WRB = (const bf16_t*)(F.ws + WS_WRT) + (size_t)L * 48 * 1024;
    const float* SGBW = (const float*)(F.ws + WS_WRT + 512 * 1024) + L * 96;
    const float* gain = a.in[I_LN1G] + L * DM; const float* bias = a.in[I_LN1B] + L * DM;
    int* TOKE = (int*)(F.ws + WS_ROUTE + RT_TOKE); float* TOKG = (float*)(F.ws + WS_ROUTE + RT_TOKG); int* TOKR = (int*)(F.ws + WS_ROUTE + RT_TOKR);
    int* BCNT = (int*)(F.ws + WS_ROUTE + RT_BCNT);
    const ldsp Wl = F.lds;
    LAS float* gl = (LAS float*)(F.lds + 99072); LAS float* bl = gl + 1024; LAS float* sb = bl + 1024;
    LAS float* lg = (LAS float*)(F.lds + 107648 + F.wave * 3136);
    LAS int* se = (LAS int*)(F.lds + 132736); LAS float* sg = (LAS float*)(se + 256); LAS int* sr = (LAS int*)(sg + 256); LAS int* cn = sr + 256;
    __syncthreads();
    stage_tile<48, 128>(Wl, RSW, (const unsigned char*)WRB, 2048, F.tid);
    if (F.tid < 256) *(LAS f32x4*)(gl + 4 * F.tid) = *(const f32x4*)(gain + 4 * F.tid); else *(LAS f32x4*)(bl + 4 * (F.tid - 256)) = *(const f32x4*)(bias + 4 * (F.tid - 256));
    if (F.tid < 96) sb[F.tid] = SGBW[F.tid];
    for (int blk = F.vcu; blk < NT / 128; blk += F.G) {
        __syncthreads();
        int lane = F.lane; asm volatile("" : "+v"(lane));
        const int r = lane & 15, g = lane >> 4;
        const size_t t0 = (size_t)blk * 128 + F.wave * 16;
        const bf16_t* yrow = YP + (t0 + r) * DM + 8 * g;
        f32x4 acc[3];
#pragma unroll
        for (int i = 0; i < 3; ++i) acc[i] = (f32x4){0.f, 0.f, 0.f, 0.f};
        float s = 0.f, q = 0.f;
#pragma unroll 1
        for (int hf = 0; hf < 2; ++hf) {
            u32x4 yv[16];
#pragma unroll
            for (int k2 = 0; k2 < 16; ++k2) yv[k2] = *(const u32x4*)(yrow + 512 * hf + 32 * k2);
            const ldsp Wh = Wl + 1024 * hf;
#pragma unroll
            for (int k2 = 0; k2 < 16; ++k2) {
                const u32x4 y4 = yv[k2];
                const bf16x8 af = __builtin_bit_cast(bf16x8, y4);
#pragma unroll
                for (int nt = 0; nt < 3; ++nt) acc[nt] = MFMA16(af, frag_row(Wh, RSW, 16 * nt, 32 * k2, lane), acc[nt]);
                const float v0 = bf_lo(y4.x), v1 = bf_hi(y4.x), v2 = bf_lo(y4.y), v3 = bf_hi(y4.y), v4 = bf_lo(y4.z), v5 = bf_hi(y4.z), v6 = bf_lo(y4.w), v7 = bf_hi(y4.w);
                s += ((v0 + v1) + (v2 + v3)) + ((v4 + v5) + (v6 + v7));
                q += ((v0 * v0 + v1 * v1) + (v2 * v2 + v3 * v3)) + ((v4 * v4 + v5 * v5) + (v6 * v6 + v7 * v7));
            }
        }
        s += __shfl_xor(s, 16); s += __shfl_xor(s, 32); q += __shfl_xor(q, 16); q += __shfl_xor(q, 32);
        const float mean = s * (1.0f / DM);
        const float rstd = 1.0f / sqrtf(fmaxf(q * (1.0f / DM) - mean * mean, 0.f) + LN_EPS);
#pragma unroll
        for (int i = 0; i < 4; ++i) {
            const float tm = __shfl(mean, 4 * g + i), tr = __shfl(rstd, 4 * g + i);
#pragma unroll
            for (int nt = 0; nt < 3; ++nt) { const int o = 16 * nt + r; lg[(4 * g + i) * 49 + o] = tr * (acc[nt][i] - tm * sb[2 * o]) + sb[2 * o + 1]; }
        }
        bf16_t* xrow = X1 + (t0 + r) * DM + 8 * g;
#pragma unroll 1
        for (int hf = 0; hf < 2; ++hf) {
            u32x4 yw[16];
#pragma unroll
            for (int k2 = 0; k2 < 16; ++k2) yw[k2] = *(const u32x4*)(yrow + 512 * hf + 32 * k2);
#pragma unroll
            for (int k2 = 0; k2 < 16; ++k2) {
                const u32x4 y4 = yw[k2]; const int kc = 512 * hf + 32 * k2 + 8 * g;
                const f32x4 v0 = {bf_lo(y4.x), bf_hi(y4.x), bf_lo(y4.y), bf_hi(y4.y)}, v1 = {bf_lo(y4.z), bf_hi(y4.z), bf_lo(y4.w), bf_hi(y4.w)};
                const f32x4 g0 = *(const LAS f32x4*)(gl + kc), g1 = *(const LAS f32x4*)(gl + kc + 4);
                const f32x4 b0 = *(const LAS f32x4*)(bl + kc), b1 = *(const LAS f32x4*)(bl + kc + 4);
                const f32x4 x0 = (v0 - mean) * rstd * g0 + b0, x1 = (v1 - mean) * rstd * g1 + b1;
                u32x4 w; w.x = pk2(x0[0], x0[1]); w.y = pk2(x0[2], x0[3]); w.z = pk2(x1[0], x1[1]); w.w = pk2(x1[2], x1[3]);
                *(u32x4*)(xrow + 512 * hf + 32 * k2) = w;
            }
        }
        if (lane < 16) {
            const LAS float* l = lg + lane * 49;
            float c0 = l[0]; int gi = 0; float cv[4]; cv[0] = c0;
#pragma unroll
            for (int k = 1; k < 4; ++k) { const float c = l[k]; cv[k] = c; if (c > c0) { c0 = c; gi = k; } }
            float den = 0.f;
#pragma unroll
            for (int k = 0; k < 4; ++k) den += __expf(cv[k] - c0);
            const float pg = 1.0f / den;
            float v1 = -3.0e38f, v2 = -3.0e38f; int i1 = 0, i2 = 0;
#pragma unroll
            for (int k = 0; k < 8; ++k) { const float f = l[4 + gi * 8 + k];
                const bool b1 = f > v1, b2 = f > v2;
                v2 = b1 ? v1 : (b2 ? f : v2); i2 = b1 ? i1 : (b2 ? k : i2); v1 = b1 ? f : v1; i1 = b1 ? k : i1; }
            const float e2 = __expf(v2 - v1), g1 = pg / (1.0f + e2), g2 = pg * e2 / (1.0f + e2);
            const int tl = F.wave * 16 + lane;
            se[2 * tl] = gi * 8 + i1; se[2 * tl + 1] = gi * 8 + i2; sg[2 * tl] = g1; sg[2 * tl + 1] = g2;
        }
        __syncthreads();
        if (F.tid < 32) { int c = 0; for (int i = 0; i < 256; ++i) { if (se[i] == F.tid) { sr[i] = c; ++c; } } cn[F.tid] = c; }
        __syncthreads();
        if (F.tid < 256) { const size_t ai = (size_t)blk * 256 + F.tid; TOKE[ai] = se[F.tid]; TOKG[ai] = sg[F.tid]; TOKR[ai] = sr[F.tid]; }
        if (F.tid < 32) BCNT[blk * 32 + F.tid] = cn[F.tid];
    }
}
__device__ __forceinline__ void m2_scatter(const Frame& F) {
    const int* TOKE = (const int*)(F.ws + WS_ROUTE + RT_TOKE); const float* TOKG = (const float*)(F.ws + WS_ROUTE + RT_TOKG); const int* TOKR = (const int*)(F.ws + WS_ROUTE + RT_TOKR);
    int* TOKP = (int*)(F.ws + WS_ROUTE + RT_TOKP); const int* BCNT = (const int*)(F.ws + WS_ROUTE + RT_BCNT);
    float* SGATE = (float*)(F.ws + WS_ROUTE + RT_SGATE); int* TILEE = (int*)(F.ws + WS_ROUTE + RT_TILEE); int* STOK = (int*)(F.ws + WS_ROUTE + RT_STOK);
    LAS int* pre = (LAS int*)F.lds; LAS int* tot = pre + 32; LAS int* start = tot + 32;
    for (int blk = F.vcu; blk < NT / 128; blk += F.G) {
        __syncthreads();
        if (F.tid < 32) { int p = 0, tt = 0; for (int b2 = 0; b2 < NT / 128; ++b2) { const int c = BCNT[b2 * 32 + F.tid]; if (b2 < blk) p += c; tt += c; } pre[F.tid] = p; tot[F.tid] = tt; }
        __syncthreads();
        if (F.tid == 0) {
            int st = 0;
            for (int e = 0; e < 32; ++e) { start[e] = st; const int nt_e = (tot[e] + 255) >> 8;
                if (blk == 0) for (int k = 0; k < nt_e; ++k) TILEE[(st >> 8) + k] = e;
                st += nt_e << 8; }
            if (blk == 0) TILEE[320] = st >> 8;
        }
        __syncthreads();
        if (F.tid < 256) { const size_t ai = (size_t)blk * 256 + F.tid; const int e = TOKE[ai]; const int p = start[e] + pre[e] + TOKR[ai]; TOKP[ai] = p; SGATE[p] = TOKG[ai]; STOK[p] = (int)(ai >> 1); }
        if (blk == 0) { const int e = F.tid >> 4; const int lo = start[e] + tot[e], hi = start[e] + (((tot[e] + 255) >> 8) << 8);
            for (int p = lo + (F.tid & 15); p < hi; p += 16) { STOK[p] = 0; SGATE[p] = 0.f; } }
    }
}
__device__ __forceinline__ void m5_combine_ln(const Frame& F, const Args& a, int L) {
    const bf16_t* X1 = (const bf16_t*)(F.ws + WS_X1B); const bf16_t* YS = (const bf16_t*)(F.ws + WS_SCR + SC_YS);
    const int* TOKP = (const int*)(F.ws + WS_ROUTE + RT_TOKP);
    bf16_t* XB = (bf16_t*)(F.ws + WS_XB);
    const float* gain = a.in[I_LN2G] + L * DM; const float* bias = a.in[I_LN2B] + L * DM;
    const int lane = F.lane;
    f32x4 gn[4], bs[4];
#pragma unroll
    for (int j = 0; j < 2; ++j) { gn[2 * j] = *(const f32x4*)(gain + 8 * lane + 512 * j); gn[2 * j + 1] = *(const f32x4*)(gain + 8 * lane + 512 * j + 4);
        bs[2 * j] = *(const f32x4*)(bias + 8 * lane + 512 * j); bs[2 * j + 1] = *(const f32x4*)(bias + 8 * lane + 512 * j + 4); }
    for (int t = F.vcu * 8 + F.wave; t < NT; t += F.G * 8) {
        const int p0 = TOKP[2 * t], p1 = TOKP[2 * t + 1];
        f32x4 v[4]; float s = 0.f;
#pragma unroll
        for (int j = 0; j < 2; ++j) {
            const u32x4 x = *(const u32x4*)(X1 + (size_t)t * DM + 8 * lane + 512 * j);
            const u32x4 y0 = *(const u32x4*)(YS + (size_t)p0 * DM + 8 * lane + 512 * j);
            const u32x4 y1 = *(const u32x4*)(YS + (size_t)p1 * DM + 8 * lane + 512 * j);
            v[2 * j][0] = ALPHA * bf_lo(x.x) + (bf_lo(y0.x) + bf_lo(y1.x)); v[2 * j][1] = ALPHA * bf_hi(x.x) + (bf_hi(y0.x) + bf_hi(y1.x));
            v[2 * j][2] = ALPHA * bf_lo(x.y) + (bf_lo(y0.y) + bf_lo(y1.y)); v[2 * j][3] = ALPHA * bf_hi(x.y) + (bf_hi(y0.y) + bf_hi(y1.y));
            v[2 * j + 1][0] = ALPHA * bf_lo(x.z) + (bf_lo(y0.z) + bf_lo(y1.z)); v[2 * j + 1][1] = ALPHA * bf_hi(x.z) + (bf_hi(y0.z) + bf_hi(y1.z));
            v[2 * j + 1][2] = ALPHA * bf_lo(x.w) + (bf_lo(y0.w) + bf_lo(y1.w)); v[2 * j + 1][3] = ALPHA * bf_hi(x.w) + (bf_hi(y0.w) + bf_hi(y1.w));
        }
#pragma unroll
        for (int j = 0; j < 4; ++j) s += (v[j][0] + v[j][1]) + (v[j][2] + v[j][3]);
        const float mean = wave_sum(s) * (1.0f / DM); float q = 0.f;
#pragma unroll
        for (int j = 0; j < 4; ++j) { v[j] = v[j] - mean; q += (v[j][0] * v[j][0] + v[j][1] * v[j][1]) + (v[j][2] * v[j][2] + v[j][3] * v[j][3]); }
        const float rstd = 1.0f / sqrtf(wave_sum(q) * (1.0f / DM) + LN_EPS);
#pragma unroll
        for (int j = 0; j < 4; ++j) v[j] = v[j] * rstd * gn[j] + bs[j];
#pragma unroll
        for (int j = 0; j < 2; ++j) {
            u32x4 o; o.x = pk2(v[2 * j][0], v[2 * j][1]); o.y = pk2(v[2 * j][2], v[2 * j][3]); o.z = pk2(v[2 * j + 1][0], v[2 * j + 1][1]); o.w = pk2(v[2 * j + 1][2], v[2 * j + 1][3]);
            *(u32x4*)(XB + (size_t)t * DM + 8 * lane + 512 * j) = o;
            if (L == DEPTH - 1) { *(f32x4*)(a.out + (size_t)t * DM + 8 * lane + 512 * j) = v[2 * j]; *(f32x4*)(a.out + (size_t)t * DM + 8 * lane + 512 * j + 4) = v[2 * j + 1]; }
        }
    }
}

__global__ void __launch_bounds__(512, 2) fwd_kernel(Args args) {
    extern __shared__ __attribute__((aligned(16))) unsigned char lds_raw[];
    Frame F;
    F.lds = (ldsp)lds_raw; F.lds_u32 = (unsigned)(size_t)lds_raw;
    F.tid = threadIdx.x; F.lane = F.tid & 63; F.wave = __builtin_amdgcn_readfirstlane(F.tid >> 6);
    F.G = gridDim.x; { const int bx = blockIdx.x; F.vcu = (F.G % 8 == 0) ? (bx % 8) * (F.G / 8) + bx / 8 : bx; }
    F.ws = args.ws;
    volatile LAS unsigned* MISC = (volatile LAS unsigned*)(F.lds + MISC_OFF);
    if (F.tid < 64) MISC[F.tid] = 0u;
    __syncthreads();
    XcdBarrier bar; bar.bar = (unsigned*)(args.ws + WS_CTL) + CW_BAR; bar.x = 0; bar.st = nullptr;
    const int lo = args.ph_lo, hi = args.ph_hi;
    if (hi - lo > 1) bar = xcd_barrier_post((unsigned*)(args.ws + WS_CTL) + CW_BAR, MISC + 8);
    int ph = 0;
#ifndef PH_MASK
#define PH_MASK 0xffffffffu
#endif
#ifndef REPEAT_MASK
#define REPEAT_MASK 0u
#endif
#define PH_BEGIN(id) if (((PH_MASK >> (id)) & 1u) && ph >= lo && ph < hi) { for (int rep_ = 0; rep_ < 1 + (int)((REPEAT_MASK >> (id)) & 1u); ++rep_) { if (rep_ > 0) xcd_barrier(bar); size_t z_ = 0; asm volatile("" : "+s"(z_)); unsigned char* ws = args.ws + z_; Frame FL = F; FL.ws = ws; { int t_ = F.tid; asm volatile("" : "+v"(t_)); FL.tid = t_; FL.lane = t_ & 63; FL.wave = __builtin_amdgcn_readfirstlane(t_ >> 6); unsigned l_ = F.lds_u32; asm volatile("" : "+s"(l_)); FL.lds_u32 = l_; FL.lds = (ldsp)(uintptr_t)l_; }
#define PH_END   } if (ph + 1 < hi) xcd_barrier(bar); } ++ph;
    const int bid = (int)blockIdx.x;

    PH_BEGIN(0) p0a_prologue(FL, args); PH_END
    PH_BEGIN(1) {
        pg8::WppOrder S{(const char*)(ws + WS_WFO), (const char*)(ws + WS_CHDFT), F.G, bid};
        pg8::EpiWpp E{(bf16_t*)(ws + WS_WPP)};
        pg8::gemm_phase<pg8::EpiWpp, pg8::WppOrder, true>(FL.lds, FL.tid, 1024, 256, 256, S, E);
    } PH_END

#pragma unroll 1
    for (int L = 0; L < DEPTH; ++L) {
        const int e = L >> 1;
        if ((L & 1) == 0) {
            PH_BEGIN(2) {
                pg8::DenseOrder S{(const char*)(ws + WS_XB), (const char*)(ws + WS_WIN) + (size_t)e * IN_EVEN * 1024 * 2, 1024, 1024, NT / 256, IN_EVEN / 256, F.G, bid};
                pg8::EpiInProj E{(bf16_t*)(ws + WS_SCR + SC_H), (const f32x2*)(ws + WS_ROPE64), (const f32x2*)(ws + WS_ROPE32)};
                pg8::gemm_phase<pg8::EpiInProj, pg8::DenseOrder, true>(FL.lds, FL.tid, 1024, 1024, 1024, S, E);
            } PH_END
            PH_BEGIN(3) a2_ret_states(FL, args.in[I_DECAY] + e * 8); PH_END
            PH_BEGIN(4) a3_ret_scan(FL, args.in[I_DECAY] + e * 8); PH_END
            PH_BEGIN(5) {
                for (int r2 = 0; r2 < 1 + (int)((REPEAT_MASK >> 16) & 1u); ++r2)
                for (int u = F.vcu; u < 1024; u += F.G) a4_ret_unit(FL, u, args.in[I_DECAY] + e * 8, args.in[I_GN] + e * 512);
                for (int r2 = 0; r2 < 1 + (int)((REPEAT_MASK >> 17) & 1u); ++r2)
                for (int u = F.vcu; u < 512; u += F.G) a4_win_unit(FL, u, args.in[I_SINK] + e * 8);
            } PH_END
            PH_BEGIN(6) {
                pg8::DenseOrder S{(const char*)(ws + WS_SCR + SC_YCAT), (const char*)(ws + WS_WOUT) + (size_t)e * 1024 * 1024 * 2, 1024, 1024, NT / 256, 4, F.G, bid};
                pg8::EpiResid E{(const bf16_t*)(ws + WS_XB), (bf16_t*)(ws + WS_SCR + SC_YPRE)};
                pg8::gemm_phase<pg8::EpiResid, pg8::DenseOrder, true>(FL.lds, FL.tid, 1024, 1024, 1024, S, E);
            } PH_END
        } else {
            PH_BEGIN(7) b1_fft_stage1(FL); PH_END
            PH_BEGIN(8) b2_fft_stage2(FL); PH_END
            PH_BEGIN(9) {
                pg8::DenseOrder S{(const char*)(ws + WS_SCR + SC_V2), (const char*)(ws + WS_WPP) + (size_t)e * 1024 * 2048 * 2, 2048, 2048, NT / 256, 4, F.G, bid};
                pg8::EpiResid E{(const bf16_t*)(ws + WS_XB), (bf16_t*)(ws + WS_SCR + SC_YPRE)};
                pg8::gemm_phase<pg8::EpiResid, pg8::DenseOrder, true>(FL.lds, FL.tid, 2048, 2048, 2048, S, E);
            } PH_END
        }
        PH_BEGIN(10) m1_ln_router(FL, args, L); PH_END
        PH_BEGIN(11) m2_scatter(FL); PH_END
        PH_BEGIN(12) {
            const int* tile_e = (const int*)(ws + WS_ROUTE + RT_TILEE);
            const int ntiles = __builtin_amdgcn_readfirstlane(tile_e[320]);
            pg8::GroupedOrder<true> S{(const char*)(ws + WS_X1B), (const char*)(ws + WS_WGU) + (size_t)L * 32 * 1024 * 1024 * 2, tile_e, (const int*)(ws + WS_ROUTE + RT_STOK), (size_t)1024 * 1024 * 2, 1024, 1024, ntiles, 4, F.G, bid};
            pg8::EpiGateUp E{(bf16_t*)(ws + WS_SCR + SC_HID)};
            pg8::gemm_phase<pg8::EpiGateUp, pg8::GroupedOrder<true>, true>(FL.lds, FL.tid, 1024, 1024, 1024, S, E);
        } PH_END
        PH_BEGIN(13) {
            const int* tile_e = (const int*)(ws + WS_ROUTE + RT_TILEE);
            const int ntiles = __builtin_amdgcn_readfirstlane(tile_e[320]);
            pg8::GroupedOrder<false> S{(const char*)(ws + WS_SCR + SC_HID), (const char*)(ws + WS_WD) + (size_t)L * 32 * 1024 * EH * 2, tile_e, nullptr, (size_t)1024 * EH * 2, EH, EH, ntiles, 4, F.G, bid};
            pg8::EpiDown E{(bf16_t*)(ws + WS_SCR + SC_YS), (const float*)(ws + WS_ROUTE + RT_SGATE)};
            pg8::gemm_phase<pg8::EpiDown, pg8::GroupedOrder<false>, true>(FL.lds, FL.tid, EH, EH, EH, S, E);
        } PH_END
        PH_BEGIN(14) m5_combine_ln(FL, args, L); PH_END
    }
#undef PH_BEGIN
#undef PH_END
}
constexpr int N_PHASES = 2 + 2 * 5 + 2 * 3 + 4 * 5;

extern "C" void kernel_launch(void* const* d_in, const int* in_sizes, int n_in, void* d_out, int out_size, void* d_ws, size_t ws_size, hipStream_t stream) {
    static int grid = 0;
    if (grid == 0) {
        if (n_in != 18 || out_size != NT * DM || ws_size < WS_END) { fprintf(stderr, "kernel_launch: unexpected shapes (n_in %d out %d ws %zu, need %zu)\n", n_in, out_size, ws_size, (size_t)WS_END); grid = -1; return; }
        int dev = 0, cus = 0, per_cu = 0;
        hipGetDevice(&dev); hipDeviceGetAttribute(&cus, hipDeviceAttributeMultiprocessorCount, dev);
        if (hipFuncSetAttribute((const void*)fwd_kernel, hipFuncAttributeMaxDynamicSharedMemorySize, LDS_BYTES) != hipSuccess) { fprintf(stderr, "kernel_launch: hipFuncSetAttribute failed\n"); grid = -1; return; }
        hipOccupancyMaxActiveBlocksPerMultiprocessor(&per_cu, (const void*)fwd_kernel, 512, LDS_BYTES);
        (void)hipGetLastError();
        if (per_cu < 1) fprintf(stderr, "kernel_launch: occupancy query says %d blocks/CU\n", per_cu);
        grid = cus > 0 ? cus : 256;
    }
    if (grid < 0) return;
    hipMemsetAsync((char*)d_ws + WS_CTL, 0, CTL_BYTES, stream);
    Args a{};
    for (int i = 0; i < 18; ++i) a.in[i] = (const float*)d_in[i];
    a.out = (float*)d_out; a.ws = (unsigned char*)d_ws;
#if N_LAUNCH_MODE == 1
    a.ph_lo = 0; a.ph_hi = N_PHASES;
    void* kargs[] = {&a};
    hipError_t le = hipLaunchCooperativeKernel((const void*)fwd_kernel, dim3(grid), dim3(512), kargs, LDS_BYTES, stream);
    if (le != hipSuccess) fprintf(stderr, "kernel_launch: cooperative launch failed: %s\n", hipGetErrorName(le));
#else
    for (int p = 0; p < N_PHASES; ++p) {
        a.ph_lo = p; a.ph_hi = p + 1;
        hipLaunchKernelGGL(fwd_kernel, dim3(grid), dim3(512), LDS_BYTES, stream, a);
    }
#endif
}
```
